# Optimizing an MI355X kernel written in HIP

```python
import math, functools
import jax, jax.numpy as jnp
from jax import lax
import numpy as np

D_MODEL = 1024
BATCH = 4
SEQ = 4096
DEPTH = 2

GRID_W = 64
CTX_LEN = 256
N_MIXERS = 2
N_A_LAYERS = (DEPTH + 1) // 2
N_B_LAYERS = DEPTH // 2
D_FF = 2816
N_MOD = 9
EPS = 1e-6
ROPE_BASE = 10000.0
Q_BLOCK = 128
NEG_INF = -1e30

A_HEADS = 8
A_HEAD_DIM = 64
A_V_DIM = 2 * A_HEAD_DIM
A_QKV_COLS = 3 * A_HEADS * A_V_DIM
A_WIDTH = A_HEADS * A_V_DIM

B_Q_HEADS = 16
B_KV_HEADS = 4
B_HEAD_DIM = 64
B_GROUP = B_Q_HEADS // B_KV_HEADS
B_QKV_COLS = (B_Q_HEADS + 2 * B_KV_HEADS) * B_HEAD_DIM
B_WIDTH = B_Q_HEADS * B_HEAD_DIM
WINDOW = 128
BAND_BLOCK = 128

kernel_name = "hybrid_diffattn_swagqa_macaron_dit"


def rms(x):
    xf = x.astype(jnp.float32)
    return (xf * lax.rsqrt(jnp.mean(xf * xf, axis=-1, keepdims=True) + EPS)).astype(x.dtype)


def rms_gain(x, g):
    return rms(x) * g


def modulate(h, shift, scale):
    return h * (1 + scale) + shift


def swiglu(h, wi, wo):
    g, u = jnp.split(h @ wi, 2, axis=-1)
    return (jax.nn.silu(g) * u) @ wo


def axial_rope_tables(rows, head_dim):
    nf = head_dim // 4
    inv = ROPE_BASE ** (-jnp.arange(nf, dtype=jnp.float32) / nf)
    row = jnp.broadcast_to(jnp.arange(rows, dtype=jnp.float32)[:, None], (rows, GRID_W)).reshape(-1)
    col = jnp.broadcast_to(jnp.arange(GRID_W, dtype=jnp.float32)[None, :], (rows, GRID_W)).reshape(-1)
    ang = jnp.stack([row[:, None] * inv, col[:, None] * inv], axis=1)
    ang = jnp.stack([ang, ang], axis=2).reshape(rows * GRID_W, head_dim)
    return jnp.cos(ang), jnp.sin(ang)


def apply_rope(x, cos, sin):
    dh = x.shape[-1]
    xr = x.reshape(x.shape[:-1] + (2, 2, dh // 4))
    rot = jnp.stack([-xr[..., 1, :], xr[..., 0, :]], axis=-2).reshape(x.shape)
    return (x * cos + rot * sin).astype(x.dtype)


def diff_attention(h_lat, h_ctx, w_qkv, w_o, q_gain, k_gain, lam_vec, subln_gain, lam_init, cos, sin, ctx_out):
    B, L, _ = h_lat.shape

    def project(h):
        q, k, v = jnp.split(h @ w_qkv, [A_WIDTH, 2 * A_WIDTH], axis=-1)
        q = rms_gain(q.reshape(B, -1, A_HEADS, 2, A_HEAD_DIM), q_gain)
        k = rms_gain(k.reshape(B, -1, A_HEADS, 2, A_HEAD_DIM), k_gain)
        return q, k, v.reshape(B, -1, A_HEADS, A_V_DIM)

    q_l, k_l, v_l = project(h_lat)
    q_c, k_c, v_c = project(h_ctx)
    rc, rs = cos[:, None, None, :], sin[:, None, None, :]
    q_l, k_l = apply_rope(q_l, rc, rs), apply_rope(k_l, rc, rs)

    lv = lam_vec.astype(jnp.float32)
    lam = jnp.exp(jnp.sum(lv[0] * lv[1])) - jnp.exp(jnp.sum(lv[2] * lv[3])) + lam_init
    scale = A_HEAD_DIM ** -0.5

    def attend(q, k, v):
        s = jnp.einsum('bqhcd,bkhcd->bhcqk', q, k).astype(jnp.float32) * scale
        p = jax.nn.softmax(s, axis=-1)
        a = (p[:, :, 0] - lam * p[:, :, 1]).astype(v.dtype)
        return jnp.einsum('bhqk,bkhe->bqhe', a, v)

    def finish(o):
        o = rms_gain(o, subln_gain) * (1.0 - lam_init)
        return o.reshape(o.shape[0], o.shape[1], A_WIDTH) @ w_o

    k_all = jnp.concatenate([k_l, k_c], axis=1)
    v_all = jnp.concatenate([v_l, v_c], axis=1)
    nb = L // Q_BLOCK
    qb = q_l.reshape(B, nb, Q_BLOCK, A_HEADS, 2, A_HEAD_DIM).transpose(1, 0, 2, 3, 4, 5)
    o_l = lax.map(lambda qblk: attend(qblk, k_all, v_all), qb)
    o_l = o_l.transpose(1, 0, 2, 3, 4).reshape(B, L, A_HEADS, A_V_DIM)
    out_l = finish(o_l)
    out_c = finish(attend(q_c, k_c, v_c)) if ctx_out else None
    return out_l, out_c


def window_gqa(h_lat, h_ctx, w_qkv, w_o, q_gain, k_gain, sink, cos, sin, ctx_out):
    B, L, _ = h_lat.shape
    nb = L // BAND_BLOCK
    BB = BAND_BLOCK

    def project(h):
        q, k, v = jnp.split(h @ w_qkv, [B_WIDTH, B_WIDTH + B_KV_HEADS * B_HEAD_DIM], axis=-1)
        q = rms_gain(q.reshape(B, -1, B_KV_HEADS, B_GROUP, B_HEAD_DIM), q_gain)
        k = rms_gain(k.reshape(B, -1, B_KV_HEADS, B_HEAD_DIM), k_gain)
        return q, k, v.reshape(B, -1, B_KV_HEADS, B_HEAD_DIM)

    q_l, k_l, v_l = project(h_lat)
    q_c, k_c, v_c = project(h_ctx)
    q_l = apply_rope(q_l, cos[:, None, None, :], sin[:, None, None, :])
    k_l = apply_rope(k_l, cos[:, None, :], sin[:, None, :])
    scale = B_HEAD_DIM ** -0.5
    sink_f = sink.astype(jnp.float32).reshape(B_KV_HEADS, B_GROUP)

    def band(t):
        tb = jnp.pad(t, ((0, 0), (BB, BB), (0, 0), (0, 0))).reshape(B, nb + 2, BB, B_KV_HEADS, B_HEAD_DIM)
        return jnp.concatenate([tb[:, :-2], tb[:, 1:-1], tb[:, 2:]], axis=2)

    k_w, v_w = band(k_l), band(v_l)
    qb = q_l.reshape(B, nb, BB, B_KV_HEADS, B_GROUP, B_HEAD_DIM)
    s_w = jnp.einsum('bnqhgd,bnkhd->bnhgqk', qb, k_w).astype(jnp.float32) * scale
    s_c = jnp.einsum('bnqhgd,bkhd->bnhgqk', qb, k_c).astype(jnp.float32) * scale
    qi = jnp.arange(BB)
    kj = jnp.arange(3 * BB)
    rel = kj[None, :] - BB - qi[:, None]
    kpos = jnp.arange(nb)[:, None] * BB - BB + kj[None, :]
    valid = (jnp.abs(rel) <= WINDOW)[None] & ((kpos >= 0) & (kpos < L))[:, None, :]
    s_w = jnp.where(valid[None, :, None, None], s_w, NEG_INF)
    sink_b = jnp.broadcast_to(sink_f[None, None, :, :, None, None], s_w.shape[:-1] + (1,))
    n_ctx = k_c.shape[1]
    p = jax.nn.softmax(jnp.concatenate([s_w, s_c, sink_b], axis=-1), axis=-1)
    p_w = p[..., :3 * BB].astype(v_w.dtype)
    p_c = p[..., 3 * BB:3 * BB + n_ctx].astype(v_c.dtype)
    o = jnp.einsum('bnhgqk,bnkhd->bnqhgd', p_w, v_w) + jnp.einsum('bnhgqk,bkhd->bnqhgd', p_c, v_c)
    out_l = o.reshape(B, L, B_WIDTH) @ w_o
    out_c = None
    if ctx_out:
        s = jnp.einsum('bqhgd,bkhd->bhgqk', q_c, k_c).astype(jnp.float32) * scale
        sb = jnp.broadcast_to(sink_f[None, :, :, None, None], s.shape[:-1] + (1,))
        pc = jax.nn.softmax(jnp.concatenate([s, sb], axis=-1), axis=-1)[..., :n_ctx].astype(v_c.dtype)
        oc = jnp.einsum('bhgqk,bkhd->bqhgd', pc, v_c)
        out_c = oc.reshape(B, n_ctx, B_WIDTH) @ w_o
    return out_l, out_c


def layer(x, xc, mod_l, mod_c, pre_wi, pre_wo, post_wi, post_wo, mixer, ctx_out):
    sh1, sc1, g1, sh2, sc2, g2, sh3, sc3, g3 = jnp.split(mod_l, N_MOD, axis=-1)
    ch1, cc1, cg1, ch2, cc2, cg2, ch3, cc3, cg3 = jnp.split(mod_c, N_MOD, axis=-1)

    def ffn_step(t, sh, sc, g, wi, wo):
        return t + 0.5 * g * swiglu(modulate(rms(t), sh, sc), wi, wo)

    x = ffn_step(x, sh1, sc1, g1, pre_wi, pre_wo)
    xc = ffn_step(xc, ch1, cc1, cg1, pre_wi, pre_wo)
    o_l, o_c = mixer(h_lat=modulate(rms(x), sh2, sc2), h_ctx=modulate(rms(xc), ch2, cc2), ctx_out=ctx_out)
    x = x + g2 * o_l
    x = ffn_step(x, sh3, sc3, g3, post_wi, post_wo)
    if ctx_out:
        xc = xc + cg2 * o_c
        xc = ffn_step(xc, ch3, cc3, cg3, post_wi, post_wo)
    return x, xc


def setup_inputs(seed: int = 0) -> dict:
    key = jax.random.key(seed)
    ks = jax.random.split(key, 24)
    f32 = jnp.float32
    D = D_MODEL

    def nrm(k, shape, s):
        return jax.random.normal(k, shape, f32) * s

    return {
        "x": nrm(ks[0], (BATCH, SEQ, D), 1.0),
        "c": nrm(ks[1], (BATCH, D), 1.0),
        "ctx": nrm(ks[2], (BATCH, CTX_LEN, D), 1.0),
        "c_ctx": nrm(ks[3], (D,), 1.0),
        "ada_w": nrm(ks[4], (DEPTH, D, N_MOD * D), 0.5 * D ** -0.5),
        "ada_b": nrm(ks[5], (DEPTH, N_MOD * D), 0.02),
        "ffn_pre_wi": nrm(ks[6], (DEPTH, D, 2 * D_FF), D ** -0.5),
        "ffn_pre_wo": nrm(ks[7], (DEPTH, D_FF, D), D_FF ** -0.5),
        "ffn_post_wi": nrm(ks[8], (DEPTH, D, 2 * D_FF), D ** -0.5),
        "ffn_post_wo": nrm(ks[9], (DEPTH, D_FF, D), D_FF ** -0.5),
        "a_w_qkv": nrm(ks[10], (N_A_LAYERS, D, A_QKV_COLS), D ** -0.5),
        "a_w_o": nrm(ks[11], (N_A_LAYERS, A_WIDTH, D), A_WIDTH ** -0.5),
        "a_q_gain": 1.0 + nrm(ks[12], (N_A_LAYERS, A_HEAD_DIM), 0.1),
        "a_k_gain": 1.0 + nrm(ks[13], (N_A_LAYERS, A_HEAD_DIM), 0.1),
        "a_lambda": nrm(ks[14], (N_A_LAYERS, 4, A_HEAD_DIM), 0.1),
        "a_subln_gain": 1.0 + nrm(ks[15], (N_A_LAYERS, A_V_DIM), 0.1),
        "b_w_qkv": nrm(ks[16], (N_B_LAYERS, D, B_QKV_COLS), D ** -0.5),
        "b_w_o": nrm(ks[17], (N_B_LAYERS, B_WIDTH, D), B_WIDTH ** -0.5),
        "b_q_gain": 1.0 + nrm(ks[18], (N_B_LAYERS, B_HEAD_DIM), 0.1),
        "b_k_gain": 1.0 + nrm(ks[19], (N_B_LAYERS, B_HEAD_DIM), 0.1),
        "b_sink": nrm(ks[20], (N_B_LAYERS, B_Q_HEADS), 0.5),
    }


def reference(x, c, ctx, c_ctx, ada_w, ada_b, ffn_pre_wi, ffn_pre_wo, ffn_post_wi, ffn_post_wo,
              a_w_qkv, a_w_o, a_q_gain, a_k_gain, a_lambda, a_subln_gain,
              b_w_qkv, b_w_o, b_q_gain, b_k_gain, b_sink):
    n_tok = x.shape[1]
    rows = n_tok // GRID_W
    cos, sin = axial_rope_tables(rows, A_HEAD_DIM)
    xc = ctx
    for i in range(DEPTH):
        mod_l = (jax.nn.silu(c) @ ada_w[i] + ada_b[i])[:, None, :]
        mod_c = jax.nn.silu(c_ctx) @ ada_w[i] + ada_b[i]
        ctx_out = i < DEPTH - 1
        j = i // N_MIXERS
        if i % N_MIXERS == 0:
            mixer = functools.partial(diff_attention, w_qkv=a_w_qkv[j], w_o=a_w_o[j], q_gain=a_q_gain[j],
                                      k_gain=a_k_gain[j], lam_vec=a_lambda[j], subln_gain=a_subln_gain[j],
                                      lam_init=0.8 - 0.6 * math.exp(-0.3 * i), cos=cos, sin=sin)
        else:
            mixer = functools.partial(window_gqa, w_qkv=b_w_qkv[j], w_o=b_w_o[j], q_gain=b_q_gain[j],
                                      k_gain=b_k_gain[j], sink=b_sink[j], cos=cos, sin=sin)
        x, xc = layer(x, xc, mod_l, mod_c, ffn_pre_wi[i], ffn_pre_wo[i], ffn_post_wi[i], ffn_post_wo[i],
                      mixer, ctx_out)
    return x
```

```cpp
#include <hip/hip_runtime.h>
#include <cstdio>
#include <cstdint>
namespace pg8 {
#define PG8_LAS __attribute__((address_space(3)))
typedef unsigned short bf16_t;
typedef short bf16x8 __attribute__((ext_vector_type(8)));
typedef float f32x4 __attribute__((ext_vector_type(4)));
typedef unsigned u32x4 __attribute__((ext_vector_type(4)));
constexpr int BM = 256, BK = 64, HALF = 128, HTB = HALF * BK * 2  , STAGE_BYTES = 8 * HTB, NXCD = 8, WGM = 4;

__host__ __device__ __forceinline__ int lds_byte(int r, int c) { const int st = (r >> 4) * 2 + (c >> 5), rr = r & 15, cc = c & 31, ob = rr * 64 + cc * 2; return st * 1024 + (ob ^ (((ob >> 9) & 1) << 5)); }
__host__ __device__ __forceinline__ void stage_rc(int b, int& R, int& C) { const int st = b / 1024, sb = b % 1024, swz = sb ^ (((sb >> 9) & 1) << 5); R = (st >> 1) * 16 + swz / 64; C = (st & 1) * 32 + (swz % 64) / 2; }
__host__ __device__ __forceinline__ int perm32(int rho) { const int n = rho >> 4, i = rho & 15; return 8 * (i >> 2) + 4 * n + (i & 3); }

struct Unit { int pm, pn, k0, nt, sp; };
struct Gemm { const bf16_t* A; const bf16_t* Bt; int M, N, K; };

struct StaticOrder {
    int nM, nN, nwg, G, c;
    __host__ __device__ void init(int M, int N, int G_, int c_) { nM = M / BM; nN = N / BM; nwg = nM * nN; G = G_; c = c_; }
    __host__ __device__ bool next(int i, Unit& u) const {
        const long L = (long)i * G + c; if (L >= nwg) return false;
        int wgid = (int)L; { const int q = nwg / NXCD, r = nwg % NXCD, xcd = wgid % NXCD, off = wgid / NXCD; wgid = (xcd < r ? xcd * (q + 1) : r * (q + 1) + (xcd - r) * q) + off; }
        const int nig = WGM * nN, gid = wgid / nig, fm = gid * WGM, gsz = (nM - fm) < WGM ? (nM - fm) : WGM;
        u.pm = fm + ((wgid % nig) % gsz); u.pn = (wgid % nig) / gsz; u.k0 = 0; u.nt = 0; u.sp = 0; return true;
    }
    __device__ __forceinline__ void a_ready(const Unit&) const {}
    __device__ __forceinline__ void done(const Unit&) const {}
};

struct SplitOrder {
    StaticOrder base; int nlat, S, q, e, nsplit, G, c;
    __host__ __device__ void init(int N, int G_, int c_, int K, bool with_ctx) { base.init(16384, N, G_, c_); nlat = base.nwg; const int ntot = K / BK; S = ntot / 4 < 8 ? ntot / 4 : 8;
        q = (ntot / S) & ~1; e = (ntot - q * S) / 2; nsplit = with_ctx ? 16 * S : 0; G = G_; c = c_; }
    __host__ __device__ bool next(int i, Unit& u) const {
        const long L = (long)i * G + c;
        Unit a; a.pm = 0; a.pn = 0; a.k0 = 0; a.nt = 0; a.sp = 0; const bool okA = base.next(i, a);
        const long jl = L - nlat; const bool okB = (jl >= 0) && (jl < nsplit); const int j = okB ? (int)jl : 0;
        const int cu = j / S, sp = j % S;
        u.pm = okA ? a.pm : 64 + (cu >> 2); u.pn = okA ? a.pn : (cu & 3); u.sp = okA ? 0 : sp;
        u.nt = okA ? 0 : (sp < e ? q + 2 : q); u.k0 = okA ? 0 : (sp < e ? sp * (q + 2) : e * (q + 2) + (sp - e) * q) * BK;
        return okA || okB;
    }
    __device__ __forceinline__ void a_ready(const Unit&) const {}
    __device__ __forceinline__ void done(const Unit&) const {}
};
__device__ __forceinline__ unsigned cvt_pk_bf16(float lo, float hi) { unsigned r; asm volatile("v_cvt_pk_bf16_f32 %0, %1, %2" : "=v"(r) : "v"(lo), "v"(hi)); return r; }
typedef float f32x2 __attribute__((ext_vector_type(2)));
typedef unsigned u32x2v __attribute__((ext_vector_type(2)));
typedef float f32x2q __attribute__((ext_vector_type(2))); typedef __bf16 bf16x2q __attribute__((ext_vector_type(2)));
__device__ __forceinline__ unsigned pk_bf16(float lo, float hi) { f32x2q v = {lo, hi}; bf16x2q b = __builtin_convertvector(v, bf16x2q); return __builtin_bit_cast(unsigned, b); }
__device__ __forceinline__ float silu_f(float g) { return g * __builtin_amdgcn_rcpf(1.f + __builtin_amdgcn_exp2f(-1.4426950408889634f * g)); }
constexpr int NLAT = 16384, DM = 1024, DFF = 2816, MODP = 18432, TKV = 4352;

struct EpiSwiglu {
    static constexpr bool PERM = true, AFTER_DRAIN = false;
    bf16_t* O;
    __device__ __forceinline__ void operator()(const f32x4 (&acc)[2][2][4][2], const Unit& u, int wr, int wc, int fr, int fq) const {
        asm volatile("" : "+v"(fr), "+v"(fq));
        const int row0 = u.pm * BM + wr * 64 + fr, col0 = u.pn * 128 + wc * 32 + 8 * fq;
#pragma unroll
        for (int ai = 0; ai < 2; ++ai)
#pragma unroll
            for (int m = 0; m < 4; ++m) { bf16_t* rowp = O + (size_t)(row0 + ai * HALF + m * 16) * DFF + col0;
                const f32x4 g0 = acc[ai][0][m][0], g1 = acc[ai][0][m][1], v0 = acc[ai][1][m][0], v1 = acc[ai][1][m][1];
                u32x4 w; w.x = pk_bf16(silu_f(g0[0]) * v0[0], silu_f(g0[1]) * v0[1]); w.y = pk_bf16(silu_f(g0[2]) * v0[2], silu_f(g0[3]) * v0[3]);
                w.z = pk_bf16(silu_f(g1[0]) * v1[0], silu_f(g1[1]) * v1[1]); w.w = pk_bf16(silu_f(g1[2]) * v1[2], silu_f(g1[3]) * v1[3]);
                *(u32x4*)rowp = w; }
    }
};
struct EpiResid {
    static constexpr bool PERM = false, AFTER_DRAIN = false;
    const float* srcL; const float* srcC; float* dstL; float* dstC; const float* gate; float* part; float coef;
    __device__ __forceinline__ void operator()(const f32x4 (&acc)[2][2][4][2], const Unit& u, int wr, int wc, int fr, int fq) const {
        asm volatile("" : "+v"(fr), "+v"(fq));
        const bool isc = u.pm >= 64;
        const float* src = isc ? srcC + (size_t)(u.pm - 64) * BM * DM : srcL + (size_t)u.pm * BM * DM;
        float* dst = isc ? dstC + (size_t)(u.pm - 64) * BM * DM : dstL + (size_t)u.pm * BM * DM;
        const int modrow = isc ? 4 : (u.pm >> 4);
        const int col0 = u.pn * BM + wc * 32 + 4 * fq;
        const float* gp = gate + modrow * MODP + col0;
        f32x4 gv[2][2];
#pragma unroll
        for (int bj = 0; bj < 2; ++bj)
#pragma unroll
            for (int n = 0; n < 2; ++n) gv[bj][n] = *(const f32x4*)(gp + bj * HALF + n * 16) * coef;
#pragma unroll
        for (int ai = 0; ai < 2; ++ai)
#pragma unroll
            for (int mp = 0; mp < 2; ++mp) {
                f32x4 xs[2][2][2];
#pragma unroll
                for (int mm = 0; mm < 2; ++mm)
#pragma unroll
                    for (int bj = 0; bj < 2; ++bj)
#pragma unroll
                        for (int n = 0; n < 2; ++n) xs[mm][bj][n] = *(const f32x4*)(src + (size_t)(ai * HALF + wr * 64 + (2 * mp + mm) * 16 + fr) * DM + col0 + bj * HALF + n * 16);
#pragma unroll
                for (int mm = 0; mm < 2; ++mm) { const int m = 2 * mp + mm; const size_t off = (size_t)(ai * HALF + wr * 64 + m * 16 + fr) * DM + col0;
#pragma unroll
                    for (int bj = 0; bj < 2; ++bj)
#pragma unroll
                        for (int n = 0; n < 2; ++n) {
                            if (u.nt) {
                                *(f32x4*)(part + ((size_t)u.sp * 1024 + (u.pm - 64) * BM) * DM + off + bj * HALF + n * 16) = gv[bj][n] * acc[ai][bj][m][n];
                            } else { *(f32x4*)(dst + off + bj * HALF + n * 16) = xs[mm][bj][n] + gv[bj][n] * acc[ai][bj][m][n]; } } }
            }
    }
};
struct EpiQKV {
    static constexpr bool PERM = false, AFTER_DRAIN = false;
    bf16_t* QK; int qk_pitch; bf16_t* VT; int nq_tiles, nqk_tiles, vw; const float* qgain; const float* kgain; float qscale;
    __device__ __forceinline__ void operator()(const f32x4 (&acc)[2][2][4][2], const Unit& u, int wr, int wc, int fr, int fq) const {
        asm volatile("" : "+v"(fr), "+v"(fq));
        const int pn = u.pn;
        if (pn < nqk_tiles) {
            const bool isq = pn < nq_tiles; const float* gain = isq ? qgain : kgain; const float osc = isq ? qscale : 1.f;
            const int colbase = pn * BM + wc * 64 + 4 * fq;
            f32x4 gv[2][2];
#pragma unroll
            for (int bj = 0; bj < 2; ++bj)
#pragma unroll
                for (int n = 0; n < 2; ++n) gv[bj][n] = *(const f32x4*)(gain + 32 * bj + 16 * n + 4 * fq);
#pragma unroll
            for (int bj = 0; bj < 2; ++bj)
#pragma unroll
                for (int n = 0; n < 2; ++n) gv[bj][n] = gv[bj][n] * osc;
            const bool lat = u.pm < 64;
            f32x4 csr[2], snr[2], csc[4], snc[4];
            if (lat) {
                float invr[4];
#pragma unroll
                for (int i = 0; i < 4; ++i) invr[i] = __builtin_amdgcn_exp2f(-(float)(4 * fq + i) * 0.8304820237218406f) * 0.15915494309189535f;
#pragma unroll
                for (int ai = 0; ai < 2; ++ai) { const float cr = (float)(((u.pm * BM + ai * HALF + wr * 64) & 4095) >> 6);
#pragma unroll
                    for (int i = 0; i < 4; ++i) { csr[ai][i] = __builtin_amdgcn_cosf(cr * invr[i]); snr[ai][i] = __builtin_amdgcn_sinf(cr * invr[i]); } }
#pragma unroll
                for (int m = 0; m < 4; ++m) { const float cc = (float)(m * 16 + fr);
#pragma unroll
                    for (int i = 0; i < 4; ++i) { csc[m][i] = __builtin_amdgcn_cosf(cc * invr[i]); snc[m][i] = __builtin_amdgcn_sinf(cc * invr[i]); } }
            }
#pragma unroll
            for (int ai = 0; ai < 2; ++ai)
#pragma unroll
                for (int m = 0; m < 4; ++m) {
                    const int row = u.pm * BM + ai * HALF + wr * 64 + m * 16 + fr;
                    float ss = 0.f;
#pragma unroll
                    for (int bj = 0; bj < 2; ++bj)
#pragma unroll
                        for (int n = 0; n < 2; ++n) { const f32x4 v = acc[ai][bj][m][n]; ss += (v[0] * v[0] + v[1] * v[1]) + (v[2] * v[2] + v[3] * v[3]); }
                    ss += __shfl_xor(ss, 16); ss += __shfl_xor(ss, 32);
                    const float rs = __builtin_amdgcn_rsqf(ss * (1.0f / 64.0f) + 1e-6f);
                    f32x4 v[2][2];
#pragma unroll
                    for (int bj = 0; bj < 2; ++bj)
#pragma unroll
                        for (int n = 0; n < 2; ++n) v[bj][n] = acc[ai][bj][m][n] * rs * gv[bj][n];
                    if (lat) {
                        { const f32x4 x0 = v[0][0], x1 = v[0][1]; v[0][0] = x0 * csr[ai] - x1 * snr[ai]; v[0][1] = x1 * csr[ai] + x0 * snr[ai]; }
                        { const f32x4 x0 = v[1][0], x1 = v[1][1]; v[1][0] = x0 * csc[m] - x1 * snc[m]; v[1][1] = x1 * csc[m] + x0 * snc[m]; }
                    }
                    bf16_t* rowp = QK + (size_t)row * qk_pitch + colbase;
#pragma unroll
                    for (int bj = 0; bj < 2; ++bj)
#pragma unroll
                        for (int n = 0; n < 2; ++n) { const f32x4 o = v[bj][n]; u32x2v w; w.x = pk_bf16(o[0], o[1]); w.y = pk_bf16(o[2], o[3]); *(u32x2v*)(rowp + 32 * bj + 16 * n) = w; }
                }
        } else {
            const int vbase = (pn - nqk_tiles) * BM + wc * 64 + 4 * fq;
#pragma unroll
            for (int ai = 0; ai < 2; ++ai)
#pragma unroll
                for (int m = 0; m < 4; ++m) {
                    const int row = u.pm * BM + ai * HALF + wr * 64 + m * 16 + fr;
                    int b, tk; if (row < NLAT) { b = row >> 12; tk = row & 4095; } else { b = (row - NLAT) >> 8; tk = 4096 + ((row - NLAT) & 255); }
                    bf16_t* vp = VT + ((size_t)b * vw + vbase) * TKV + tk;
#pragma unroll
                    for (int bj = 0; bj < 2; ++bj)
#pragma unroll
                        for (int n = 0; n < 2; ++n) { const f32x4 o = acc[ai][bj][m][n]; const unsigned w0 = pk_bf16(o[0], o[1]), w1 = pk_bf16(o[2], o[3]);
                            bf16_t* q = vp + (size_t)(32 * bj + 16 * n) * TKV;
                            q[0] = (bf16_t)(w0 & 0xffffu); q[TKV] = (bf16_t)(w0 >> 16); q[2 * TKV] = (bf16_t)(w1 & 0xffffu); q[3 * TKV] = (bf16_t)(w1 >> 16); }
                }
        }
    }
};
template <class Epi, class Sched, bool ALIGN_EPI = false, bool SP2 = false>
__device__ __forceinline__ void gemm_phase(PG8_LAS unsigned char* lds, const Gemm g, const Sched& S, const Epi& E) {
    int tid_o = threadIdx.x; asm volatile("" : "+v"(tid_o));
    const int tid = tid_o, wid = __builtin_amdgcn_readfirstlane(tid >> 6), lane = tid & 63, wr = wid >> 2, wc = wid & 3, fr = lane & 15, fq = lane >> 4;
    const int K = g.K, nt = K / BK;
    unsigned voffA[2], voffB[2];
#pragma unroll
    for (int i = 0; i < 2; ++i) { int R, C; stage_rc(tid * 16 + i * 8192, R, C); const int Rb = Epi::PERM ? ((R & ~31) + perm32(R & 31)) : R;
        voffA[i] = (unsigned)(R * K + C) * 2u; voffB[i] = (unsigned)(Rb * K + C) * 2u; }
    const size_t kstep = (size_t)(BK * 2);
    const size_t hstep = (size_t)HALF * K * 2;
    const size_t tstep = 2 * hstep;
    const unsigned ldsw = (unsigned)wid * 1024u;
    const int aoff = lds_byte(wr * 64 + fr, fq * 8), boff = lds_byte(wc * 32 + fr, fq * 8);
#define PG8_SA(b, h) (((b) * 2 + (h)) * HTB)
#define PG8_SB(b, h) ((4 + (b) * 2 + (h)) * HTB)
#define PG8_STAGE(bufoff, gbase, voff) do { _Pragma("unroll") for (int _i = 0; _i < 2; ++_i) \
        __builtin_amdgcn_global_load_lds((const unsigned*)((const char*)(gbase) + (voff)[_i]), (PG8_LAS unsigned*)(lds + (bufoff) + ldsw + _i * 8192), 16, 0, 0); } while (0)
#define PG8_LDA(dst, b, h) do { _Pragma("unroll") for (int m = 0; m < 4; ++m) _Pragma("unroll") for (int k = 0; k < 2; ++k) dst[m][k] = *(const PG8_LAS bf16x8*)(lds + PG8_SA(b, h) + aoff + m * 2048 + k * 1024); } while (0)
#define PG8_LDB(dst, b, h) do { _Pragma("unroll") for (int n = 0; n < 2; ++n) _Pragma("unroll") for (int k = 0; k < 2; ++k) dst[n][k] = *(const PG8_LAS bf16x8*)(lds + PG8_SB(b, h) + boff + n * 2048 + k * 1024); } while (0)
#define PG8_MMA(ai, bj, At, Bt) do { __builtin_amdgcn_s_setprio(1); _Pragma("unroll") for (int m = 0; m < 4; ++m) _Pragma("unroll") for (int n = 0; n < 2; ++n) _Pragma("unroll") for (int k = 0; k < 2; ++k) \
        acc[ai][bj][m][n] = __builtin_amdgcn_mfma_f32_16x16x32_bf16(Bt[n][k], At[m][k], acc[ai][bj][m][n], 0, 0, 0); __builtin_amdgcn_s_setprio(0); } while (0)
#define PG8_WAIT_V(n) asm volatile("s_waitcnt vmcnt(" #n ")" ::: "memory")
#define PG8_WAIT_L(n) asm volatile("s_waitcnt lgkmcnt(" #n ")" ::: "memory")
#define PG8_BAR __builtin_amdgcn_s_barrier()
#define PG8_SCHED __builtin_amdgcn_sched_barrier(0)
    Unit cur, nxt; int ui = 0;
    if (!S.next(0, cur)) return;
    f32x4 acc[2][2][4][2];
#pragma unroll
    for (int a = 0; a < 2; ++a)
#pragma unroll
        for (int b = 0; b < 2; ++b)
#pragma unroll
            for (int m = 0; m < 4; ++m)
#pragma unroll
                for (int n = 0; n < 2; ++n) acc[a][b][m][n] = (f32x4){0.f, 0.f, 0.f, 0.f};
    bf16x8 At[4][2], B0[2][2], B1[2][2];
    const char* cA = (const char*)g.A + (size_t)cur.pm * tstep + (size_t)cur.k0 * 2; const char* cB = (const char*)g.Bt + (size_t)cur.pn * tstep + (size_t)cur.k0 * 2;
    S.a_ready(cur);
    if constexpr (SP2) {
        PG8_STAGE(PG8_SB(0, 0), cB, voffB); PG8_STAGE(PG8_SB(0, 1), cB + hstep, voffB); PG8_STAGE(PG8_SA(0, 0), cA, voffA); PG8_STAGE(PG8_SA(0, 1), cA + hstep, voffA);
        if (wr == 1) PG8_BAR;
        PG8_WAIT_V(2); PG8_BAR;
        PG8_STAGE(PG8_SB(1, 0), cB + kstep, voffB); PG8_STAGE(PG8_SA(1, 0), cA + kstep, voffA); PG8_STAGE(PG8_SB(1, 1), cB + hstep + kstep, voffB);
        PG8_WAIT_V(6); PG8_BAR;
    } else {
        PG8_STAGE(PG8_SB(0, 0), cB, voffB); PG8_STAGE(PG8_SA(0, 0), cA, voffA); PG8_STAGE(PG8_SB(0, 1), cB + hstep, voffB); PG8_STAGE(PG8_SA(0, 1), cA + hstep, voffA);
        if (wr == 1) PG8_BAR;
        PG8_WAIT_V(4); PG8_BAR;
        PG8_STAGE(PG8_SB(1, 0), cB + kstep, voffB); PG8_STAGE(PG8_SA(1, 0), cA + kstep, voffA); PG8_STAGE(PG8_SB(1, 1), cB + hstep + kstep, voffB);
        PG8_WAIT_V(6); PG8_BAR;
    }
    for (;;) {
        const bool has_next = S.next(ui + 1, nxt);
        const char* nA = has_next ? (const char*)g.A + (size_t)nxt.pm * tstep + (size_t)nxt.k0 * 2 : cA; const char* nB = has_next ? (const char*)g.Bt + (size_t)nxt.pn * tstep + (size_t)nxt.k0 * 2 : cB;
        const int unt = cur.nt ? cur.nt : nt;
        for (int t = 0; t < unt; t += 2) {
            const bool last = (t == unt - 2);
            const char* a1 = cA + (size_t)(t + 1) * kstep;
            const char* a2 = last ? nA : cA + (size_t)(t + 2) * kstep; const char* b2 = last ? nB : cB + (size_t)(t + 2) * kstep;
            const char* a3 = a2 + kstep; const char* b3 = b2 + kstep;
            if (last && has_next) S.a_ready(nxt);
            if constexpr (SP2) {
            PG8_LDB(B0, 0, 0); PG8_LDB(B1, 0, 1); PG8_SCHED; PG8_LDA(At, 0, 0); PG8_STAGE(PG8_SA(1, 1), a1 + hstep, voffA);
            PG8_WAIT_V(8); PG8_WAIT_L(0); PG8_BAR; PG8_MMA(0, 0, At, B0); PG8_MMA(0, 1, At, B1); PG8_BAR; PG8_SCHED;
            PG8_LDA(At, 0, 1); PG8_STAGE(PG8_SB(0, 0), b2, voffB); PG8_STAGE(PG8_SB(0, 1), b2 + hstep, voffB); PG8_STAGE(PG8_SA(0, 0), a2, voffA);
            PG8_WAIT_V(8); PG8_WAIT_L(0); PG8_BAR; PG8_MMA(1, 0, At, B0); PG8_MMA(1, 1, At, B1); PG8_BAR; PG8_SCHED;
            PG8_LDB(B0, 1, 0); PG8_LDB(B1, 1, 1); PG8_SCHED; PG8_LDA(At, 1, 0); PG8_STAGE(PG8_SA(0, 1), a2 + hstep, voffA);
            PG8_WAIT_V(8); PG8_WAIT_L(0); PG8_BAR; PG8_MMA(0, 0, At, B0); PG8_MMA(0, 1, At, B1); PG8_BAR; PG8_SCHED;
            PG8_LDA(At, 1, 1); PG8_STAGE(PG8_SB(1, 0), b3, voffB); PG8_STAGE(PG8_SB(1, 1), b3 + hstep, voffB); PG8_STAGE(PG8_SA(1, 0), a3, voffA);
            PG8_WAIT_V(8); PG8_WAIT_L(0); PG8_BAR; PG8_MMA(1, 0, At, B0); PG8_MMA(1, 1, At, B1); PG8_BAR; PG8_SCHED;
            } else {
            PG8_LDB(B0, 0, 0); PG8_SCHED; PG8_LDA(At, 0, 0); PG8_STAGE(PG8_SA(1, 1), a1 + hstep, voffA);
            PG8_WAIT_L(8); PG8_BAR; PG8_WAIT_L(0); PG8_MMA(0, 0, At, B0); PG8_BAR; PG8_SCHED;
            PG8_LDB(B1, 0, 1); PG8_STAGE(PG8_SB(0, 0), b2, voffB);
            PG8_BAR; PG8_WAIT_L(0); PG8_MMA(0, 1, At, B1); PG8_BAR;
            PG8_LDA(At, 0, 1); PG8_STAGE(PG8_SA(0, 0), a2, voffA);
            PG8_BAR; PG8_WAIT_L(0); PG8_MMA(1, 0, At, B0); PG8_BAR; PG8_SCHED;
            PG8_STAGE(PG8_SB(0, 1), b2 + hstep, voffB);
            PG8_WAIT_V(6); PG8_BAR; PG8_MMA(1, 1, At, B1); PG8_BAR;
            PG8_LDB(B0, 1, 0); PG8_SCHED; PG8_LDA(At, 1, 0); PG8_STAGE(PG8_SA(0, 1), a2 + hstep, voffA);
            PG8_WAIT_L(8); PG8_BAR; PG8_WAIT_L(0); PG8_MMA(0, 0, At, B0); PG8_BAR; PG8_SCHED;
            PG8_LDB(B1, 1, 1); PG8_STAGE(PG8_SB(1, 0), b3, voffB);
            PG8_BAR; PG8_WAIT_L(0); PG8_MMA(0, 1, At, B1); PG8_BAR;
            PG8_LDA(At, 1, 1); PG8_STAGE(PG8_SA(1, 0), a3, voffA);
            PG8_BAR; PG8_WAIT_L(0); PG8_MMA(1, 0, At, B0); PG8_BAR; PG8_SCHED;
            PG8_STAGE(PG8_SB(1, 1), b3 + hstep, voffB);
            PG8_WAIT_V(6); PG8_BAR; PG8_MMA(1, 1, At, B1); PG8_BAR;
            }
        }
        if constexpr (ALIGN_EPI) { if (wr == 0) PG8_BAR; }
        if constexpr (!Epi::AFTER_DRAIN) { E(acc, cur, wr, wc, fr, fq); S.done(cur); }
        if (!has_next) break;
#pragma unroll
        for (int a = 0; a < 2; ++a)
#pragma unroll
            for (int b = 0; b < 2; ++b)
#pragma unroll
                for (int m = 0; m < 4; ++m)
#pragma unroll
                    for (int n = 0; n < 2; ++n) acc[a][b][m][n] = (f32x4){0.f, 0.f, 0.f, 0.f};
        cur = nxt; cA = nA; cB = nB; ++ui;
        if constexpr (ALIGN_EPI) { if (wr == 1) PG8_BAR; }
    }
    PG8_WAIT_V(0);
    if constexpr (!ALIGN_EPI) { if (wr == 0) PG8_BAR; }
    PG8_BAR;
    if constexpr (Epi::AFTER_DRAIN) { E.fused(acc, cur, wr, wc, fr, fq, lds, wid, lane); S.done(cur); }
#undef PG8_SA
#undef PG8_SB
#undef PG8_STAGE
#undef PG8_LDA
#undef PG8_LDB
#undef PG8_MMA
#undef PG8_WAIT_V
#undef PG8_WAIT_L
#undef PG8_BAR
#undef PG8_SCHED
}
}

#define LAS __attribute__((address_space(3)))
typedef unsigned short bf16_t;
typedef short bf16x8 __attribute__((ext_vector_type(8)));
typedef short s16x4 __attribute__((ext_vector_type(4)));
typedef float f32x4 __attribute__((ext_vector_type(4)));
typedef float f32x16 __attribute__((ext_vector_type(16)));
typedef unsigned u32x4 __attribute__((ext_vector_type(4)));
typedef unsigned u32x2 __attribute__((ext_vector_type(2)));
using pg8::pk_bf16;
constexpr int NWAVES = 8, NTHREADS = 512;
constexpr int NLAT = 16384, NCTX = 1024, MROWS = NLAT + NCTX, DM = 1024, DFF = 2816, MODP = 18432, TKV = 4352;
constexpr int LDS_MISC = 131072, LDS_BYTES = 131072 + 64;
constexpr size_t MiB = 1u << 20;
constexpr size_t WS_BAR = 0, BAR_ZERO_BYTES = 16384, WS_MOD = 65536, WS_MODP = 1 * MiB, WS_XC = 8 * MiB, WS_W = 12 * MiB;
constexpr size_t WI_B = (size_t)2 * DFF * DM * 2, WO_B = (size_t)DM * DFF * 2;
constexpr size_t WS_FFN0 = WS_W;
constexpr size_t FFN_L_B = 2 * (WI_B + WO_B);
constexpr size_t WS_QKVA = WS_FFN0 + 2 * FFN_L_B, WS_WOA = WS_QKVA + 6 * MiB, WS_QKVB = WS_WOA + 2 * MiB, WS_WOB = WS_QKVB + 3 * MiB;
constexpr size_t WS_H = WS_WOB + 2 * MiB + 1 * MiB;
constexpr size_t WS_BIG = WS_H + 34 * MiB;
constexpr size_t WS_VT_OFF = 68 * MiB;
constexpr size_t WS_PART = WS_BIG + 102 * MiB;
constexpr size_t WS_END = WS_PART + 32 * MiB;
static_assert(WS_END <= 272 * MiB, "ws map");
static_assert((size_t)MROWS * DFF * 2 <= 102 * MiB && (size_t)MROWS * 2048 * 2 <= WS_VT_OFF, "big region");
constexpr int KC_MOD = 16;

#define XB_TMO      128
#define XB_XCNT(j)  (256  + 64 * (j))
#define XB_XSUB(j)  (1280 + 64 * (j))
#define XB_XGEN(j)  (2304 + 64 * (j))
#define XB_TOP      3328
#define XB_TOPGEN   3392
#define XCD_BAR_WORDS 3456
#define XB_SPIN_CAP (1u << 18)

__device__ __forceinline__ unsigned xb_ld(unsigned* p)              { return __hip_atomic_load(p, __ATOMIC_RELAXED, __HIP_MEMORY_SCOPE_AGENT); }
__device__ __forceinline__ unsigned xb_add(unsigned* p, unsigned v) { return __hip_atomic_fetch_add(p, v, __ATOMIC_RELAXED, __HIP_MEMORY_SCOPE_AGENT); }
__device__ __forceinline__ unsigned xb_xcc_id() { return (unsigned)__builtin_amdgcn_s_getreg((3 << 11) | 20) & 0xFu; }
#define XB_SPIN(cond, bar) do { unsigned _sp = 0; while (cond) { __builtin_amdgcn_s_sleep(1); \
    if ((++_sp & 255u) == 0u) { if (xb_ld(&(bar)[XB_TMO])) break; if (_sp > XB_SPIN_CAP) { atomicAdd(&(bar)[XB_TMO], 1u); break; } } } } while (0)

struct XcdBarrier {
    unsigned* bar; unsigned x;
    volatile LAS unsigned* st;
};

__device__ __forceinline__ XcdBarrier xcd_barrier_post(unsigned* bar, volatile LAS unsigned* st) {
    XcdBarrier b; b.bar = bar; b.x = xb_xcc_id(); b.st = st;
    if (threadIdx.x == 0) (void)xb_add(&bar[XB_XCNT(b.x)], 1u);
    return b;
}
__device__ __forceinline__ void xcd_barrier_complete(unsigned* bar, unsigned x, unsigned& nloc, unsigned& nx) {
    const unsigned G = gridDim.x * gridDim.y * gridDim.z;
    unsigned sum, cnt, mine, sp = 0u;
    for (;;) {
        sum = 0u; cnt = 0u; mine = 0u;
#pragma unroll
        for (unsigned j = 0; j < 16; ++j) { const unsigned c = xb_ld(&bar[XB_XCNT(j)]); sum += c; cnt += (c > 0u) ? 1u : 0u; mine = (j == x) ? c : mine; }
        if (sum == G) break;
        __builtin_amdgcn_s_sleep(1);
        if ((++sp & 255u) == 0u) { if (xb_ld(&bar[XB_TMO])) break; if (sp > XB_SPIN_CAP) { atomicAdd(&bar[XB_TMO], 1u); break; } }
    }
    nloc = mine > 0u ? mine : 1u; nx = cnt > 0u ? cnt : 1u;
}

__device__ __forceinline__ void xcd_barrier(const XcdBarrier& b) {
    asm volatile("s_waitcnt vmcnt(0)" ::: "memory");
    __syncthreads();
    if (threadIdx.x == 0) {
        unsigned* bar = b.bar;
        __builtin_amdgcn_s_waitcnt(0);
        unsigned nloc = b.st[0], nx = b.st[1];
        if (nloc == 0u) { xcd_barrier_complete(bar, b.x, nloc, nx); b.st[0] = nloc; b.st[1] = nx; }
        const unsigned old = xb_add(&bar[XB_XSUB(b.x)], 1u);
        const unsigned gen = old / nloc;
        if (old + 1u == (gen + 1u) * nloc) {
            __builtin_amdgcn_fence(__ATOMIC_RELEASE, "agent");
            asm volatile("s_waitcnt vmcnt(0)" ::: "memory");
            const unsigned og = xb_add(&bar[XB_TOP], 1u);
            const unsigned tg = og / nx;
            if (og + 1u == (tg + 1u) * nx) xb_add(&bar[XB_TOPGEN], 1u);
            else XB_SPIN(xb_ld(&bar[XB_TOPGEN]) == tg, bar);
            __builtin_amdgcn_fence(__ATOMIC_ACQUIRE, "agent");
            xb_add(&bar[XB_XGEN(b.x)], 1u);
            asm volatile("s_waitcnt vmcnt(0)" ::: "memory");
        } else {
            XB_SPIN(xb_ld(&bar[XB_XGEN(b.x)]) == gen, bar);
            __builtin_amdgcn_fence(__ATOMIC_ACQUIRE, "agent");
            asm volatile("s_waitcnt vmcnt(0)" ::: "memory");
        }
    }
    __syncthreads();
}

__device__ __forceinline__ float wave_sum(float v) {
#pragma unroll
    for (int o = 1; o < 64; o <<= 1) v += __shfl_xor(v, o);
    return v;
}

__device__ __forceinline__ int srcblk(int kind, int nb) {
    if (kind == 1) { const int pn = nb >> 3, s = (nb >> 2) & 1, jb = nb & 3; return s * 88 + 4 * pn + jb; }
    if (kind == 2) { const int pn = nb >> 3, bj = (nb >> 2) & 1, wc = nb & 3; return 8 * pn + 2 * wc + bj; }
    return nb;
}
__device__ __forceinline__ void transpose_item(const float* W, int K, int N, bf16_t* WT, int kind, LAS float* scr, int item, int lane) {
    const int nblk = N / 32, kb = item / nblk, nb = item % nblk, k0 = 64 * kb, n0s = 32 * srcblk(kind, nb), n0d = 32 * nb;
    { float t_[32];
#pragma unroll
      for (int i = 0; i < 32; ++i) t_[i] = W[(size_t)(k0 + 2 * i + (lane >> 5)) * N + n0s + (lane & 31)];
#pragma unroll
      for (int i = 0; i < 32; ++i) scr[(2 * i + (lane >> 5)) * 33 + (lane & 31)] = t_[i]; }
    asm volatile("s_waitcnt lgkmcnt(0)" ::: "memory");
    const int c = lane & 7;
#pragma unroll
    for (int j = 0; j < 4; ++j) { const int n = (lane >> 3) + 8 * j; const LAS float* s = scr + (8 * c) * 33 + n;
        u32x4 o; o.x = pk_bf16(s[0 * 33], s[1 * 33]); o.y = pk_bf16(s[2 * 33], s[3 * 33]); o.z = pk_bf16(s[4 * 33], s[5 * 33]); o.w = pk_bf16(s[6 * 33], s[7 * 33]);
        *(u32x4*)(WT + (size_t)(n0d + n) * K + k0 + 8 * c) = o; }
    asm volatile("s_waitcnt lgkmcnt(0)" ::: "memory");
}
__device__ __forceinline__ void mod_item(const float* c, const float* cctx, const float* adaw, float* part, LAS float* scr, int item, int lane) {
    const int kc = item / 72, cc = item % 72, n0 = 256 * cc, layer = n0 / 9216, col = n0 % 9216, k0 = 64 * kc;
#pragma unroll
    for (int r = 0; r < 5; ++r) { const float v = (r < 4) ? c[r * DM + k0 + lane] : cctx[k0 + lane]; scr[r * 64 + lane] = pg8::silu_f(v); }
    asm volatile("s_waitcnt lgkmcnt(0)" ::: "memory");
    const float* wp = adaw + ((size_t)layer * DM + k0) * 9216 + col + 4 * lane;
    f32x4 a0 = {0, 0, 0, 0}, a1 = a0, a2 = a0, a3 = a0, a4 = a0;
#pragma unroll 16
    for (int kk = 0; kk < 64; ++kk) { const f32x4 w = *(const f32x4*)(wp + (size_t)kk * 9216);
        a0 += w * scr[kk]; a1 += w * scr[64 + kk]; a2 += w * scr[128 + kk]; a3 += w * scr[192 + kk]; a4 += w * scr[256 + kk]; }
    float* pp = part + (size_t)kc * 5 * MODP + n0 + 4 * lane;
    *(f32x4*)(pp) = a0; *(f32x4*)(pp + MODP) = a1; *(f32x4*)(pp + 2 * MODP) = a2; *(f32x4*)(pp + 3 * MODP) = a3; *(f32x4*)(pp + 4 * MODP) = a4;
    asm volatile("s_waitcnt lgkmcnt(0)" ::: "memory");
}

template <int NS> __device__ __forceinline__ void norm_fold(f32x4 (&v)[4], int crow_, float* xc, const float* part, int lane) {
#pragma unroll
    for (int j = 0; j < 4; ++j) { const float* pp = part + (size_t)crow_ * DM + 4 * lane + 256 * j; f32x4 t[NS];
#pragma unroll
        for (int sp = 0; sp < NS; ++sp) t[sp] = *(const f32x4*)(pp + (size_t)sp * NCTX * DM);
#pragma unroll
        for (int sp = 0; sp < NS; ++sp) v[j] += t[sp];
        *(f32x4*)(xc + (size_t)crow_ * DM + 4 * lane + 256 * j) = v[j]; }
}
__device__ __forceinline__ void norm_finish(const f32x4 (&v)[4], int row, bf16_t* H, const f32x4 (&s4)[4], const f32x4 (&h4)[4], int lane) {
    float ss = 0.f;
#pragma unroll
    for (int j = 0; j < 4; ++j) ss += (v[j][0] * v[j][0] + v[j][1] * v[j][1]) + (v[j][2] * v[j][2] + v[j][3] * v[j][3]);
    const float rstd = 1.0f / sqrtf(wave_sum(ss) * (1.0f / DM) + 1e-6f);
#pragma unroll
    for (int j = 0; j < 4; ++j) { const int col = 4 * lane + 256 * j;
        const f32x4 o = (v[j] * rstd) * (s4[j] + 1.0f) + h4[j]; u32x2 w; w.x = pk_bf16(o[0], o[1]); w.y = pk_bf16(o[2], o[3]); *(u32x2*)(H + (size_t)row * DM + col) = w; }
}
__device__ __forceinline__ void norm_phase(const float* xl, float* xc, const float* part, int nsplit, bf16_t* H, const float* modsh, int nrows, int gw, int ngw, int lane) {
    for (int row = gw; row < nrows; row += 2 * ngw) {
        const int rb = row + ngw; const bool hb = rb < nrows;
        const float* xa = (row < NLAT) ? xl + (size_t)row * DM : xc + (size_t)(row - NLAT) * DM;
        const float* xb = !hb ? xa : (rb < NLAT) ? xl + (size_t)rb * DM : xc + (size_t)(rb - NLAT) * DM;
        const int mra = (row < NLAT) ? (row >> 12) : 4, mrb = !hb ? mra : (rb < NLAT) ? (rb >> 12) : 4;
        f32x4 va[4], vb[4], s4[4], h4[4];
#pragma unroll
        for (int j = 0; j < 4; ++j) va[j] = *(const f32x4*)(xa + 4 * lane + 256 * j);
#pragma unroll
        for (int j = 0; j < 4; ++j) vb[j] = *(const f32x4*)(xb + 4 * lane + 256 * j);
#pragma unroll
        for (int j = 0; j < 4; ++j) { h4[j] = *(const f32x4*)(modsh + mra * MODP + 4 * lane + 256 * j); s4[j] = *(const f32x4*)(modsh + mra * MODP + DM + 4 * lane + 256 * j); }
        if (row >= NLAT && nsplit > 0) { if (nsplit == 8) norm_fold<8>(va, row - NLAT, xc, part, lane); else norm_fold<4>(va, row - NLAT, xc, part, lane); }
        if (hb && rb >= NLAT && nsplit > 0) { if (nsplit == 8) norm_fold<8>(vb, rb - NLAT, xc, part, lane); else norm_fold<4>(vb, rb - NLAT, xc, part, lane); }
        norm_finish(va, row, H, s4, h4, lane);
        if (hb) {
            if (mrb != mra) {
#pragma unroll
                for (int j = 0; j < 4; ++j) { h4[j] = *(const f32x4*)(modsh + mrb * MODP + 4 * lane + 256 * j); s4[j] = *(const f32x4*)(modsh + mrb * MODP + DM + 4 * lane + 256 * j); } }
            norm_finish(vb, rb, H, s4, h4, lane);
        }
    }
}

__device__ __forceinline__ int crow(int i, int h) { return (i & 3) + 8 * (i >> 2) + 4 * h; }
#define MFMA32(a, b, c) __builtin_amdgcn_mfma_f32_32x32x16_bf16((a), (b), (c), 0, 0, 0)
__device__ __forceinline__ float max3f(float a, float b, float c) { return __builtin_fmaxf(__builtin_fmaxf(a, b), c); }
template <bool TB>
__device__ __forceinline__ void attn_phase(LAS unsigned char* lds, const bf16_t* QK, const bf16_t* VT, bf16_t* O, const float* lamvec, const float* subln, const float* sink, int nblocks, int bid) {
    constexpr int DV = TB ? 64 : 128, NB = DV / 32;
    constexpr int QKP = TB ? 1280 : 2048, VW = TB ? 256 : 1024;
    constexpr int KROWB = TB ? 128 : 256, KS = KROWB + 16, VS = 144;
    constexpr int KBUF = 64 * KS, VBUF = DV * VS;
    constexpr int NKC = KROWB / 128, NVC = DV / 64;
    constexpr int KCPR = KROWB / 16;
    static_assert(2 * KBUF + 2 * VBUF <= LDS_BYTES && (TB || 4 * 64 * 64 * 4 <= 2 * KBUF + 2 * VBUF), "attn lds");
    int tid_o = threadIdx.x; asm volatile("" : "+v"(tid_o));
    const int tid = tid_o, lane = tid & 63, wid = __builtin_amdgcn_readfirstlane(tid >> 6), r32 = lane & 31, h = lane >> 5;
    const int wq = wid & 3, wsel = wid >> 2;
    float lam = 0.f;
    if (!TB) { float a = lamvec[lane] * lamvec[64 + lane], b = lamvec[128 + lane] * lamvec[192 + lane]; a = wave_sum(a); b = wave_sum(b); lam = expf(a) - expf(b) + 0.2f; }
    const int nunits = TB ? 1024 : 1088;
    for (int u = bid; u < nunits; u += nblocks) {
        int b, head, qb, kvh = 0; bool isctx = false;
        if (!TB) {
            if (u < 1024) { const int bh = (u >> 8) * 8 + (u & 7); qb = (u & 255) >> 3; b = bh >> 3; head = bh & 7; }
            else { const int v = u - 1024; b = v >> 4; head = (v >> 1) & 7; qb = v & 1; isctx = true; }
        } else { b = u >> 8; qb = (u >> 3) & 31; kvh = (u >> 1) & 3; head = kvh * 4 + (u & 1) * 2 + wsel; }
        int t1, n1;
        if (!TB) { t1 = 0; n1 = isctx ? 0 : 64; } else { t1 = (2 * qb - 2 > 0) ? 2 * qb - 2 : 0; const int te = (2 * qb + 4 < 64) ? 2 * qb + 4 : 64; n1 = te - t1; }
        const int ntiles = n1 + 4;
        const int qpos = qb * 128 + 32 * wq + r32;
        const int qrow = isctx ? NLAT + b * 256 + qpos : b * 4096 + qpos;
        const int qcol = TB ? head * 64 : head * 128 + wsel * 64;
        bf16x8 qr[4];
        { const bf16_t* qp = QK + (size_t)qrow * QKP + qcol + 8 * h;
#pragma unroll
          for (int d0 = 0; d0 < 4; ++d0) qr[d0] = *(const bf16x8*)(qp + 16 * d0); }
        const bf16_t* kg = QK + 1024 + (TB ? kvh * 64 : head * 128);
        const bf16_t* vg = VT + ((size_t)b * VW + (TB ? kvh * 64 : head * 128)) * TKV;
        u32x4 kst[NKC], vst[NVC];
#define TILE_OF(s) (((s) < n1) ? t1 + (s) : 64 + (s) - n1)
#define G_LOAD(s) do { const int t_ = TILE_OF(s); const int krow_ = (t_ < 64) ? b * 4096 + 64 * t_ : NLAT + b * 256 + 64 * (t_ - 64); \
        _Pragma("unroll") for (int i_ = 0; i_ < NKC; ++i_) { const int c_ = tid + 512 * i_; kst[i_] = *(const u32x4*)(kg + (size_t)(krow_ + c_ / KCPR) * QKP + (c_ % KCPR) * 8); } \
        _Pragma("unroll") for (int i_ = 0; i_ < NVC; ++i_) { const int c_ = tid + 512 * i_; vst[i_] = *(const u32x4*)(vg + (size_t)(c_ >> 3) * TKV + 64 * t_ + (c_ & 7) * 8); } } while (0)
#define L_STORE(buf) do { LAS unsigned char* kb_ = lds + (buf) * KBUF; LAS unsigned char* vb_ = lds + 2 * KBUF + (buf) * VBUF; \
        _Pragma("unroll") for (int i_ = 0; i_ < NKC; ++i_) { const int c_ = tid + 512 * i_; *(LAS u32x4*)(kb_ + (c_ / KCPR) * KS + (c_ % KCPR) * 16) = kst[i_]; } \
        _Pragma("unroll") for (int i_ = 0; i_ < NVC; ++i_) { const int c_ = tid + 512 * i_; LAS unsigned char* p_ = vb_ + (c_ >> 3) * VS + ((c_ & 7) >> 1) * 32 + (c_ & 1) * 8; \
            *(LAS u32x2*)(p_) = (u32x2){vst[i_].x, vst[i_].y}; *(LAS u32x2*)(p_ + 16) = (u32x2){vst[i_].z, vst[i_].w}; } } while (0)
        constexpr float THR = 8.0f;
        float m_ref; f32x16 osum;
        { const float l0 = TB ? 1.f : 0.f;
#pragma unroll
          for (int i = 0; i < 16; ++i) osum[i] = l0; }
        if (TB) m_ref = sink[head] * 1.4426950408889634f; else m_ref = 0.f;
        const bf16x8 ones8 = (bf16x8){0x3F80, 0x3F80, 0x3F80, 0x3F80, 0x3F80, 0x3F80, 0x3F80, 0x3F80};
        f32x16 negm;
#pragma unroll
        for (int i = 0; i < 16; ++i) negm[i] = -m_ref;
        f32x16 o[NB];
#pragma unroll
        for (int blk = 0; blk < NB; ++blk)
#pragma unroll
            for (int i = 0; i < 16; ++i) o[blk][i] = 0.f;
        G_LOAD(0); L_STORE(0); G_LOAD(1); __syncthreads();
        for (int s = 0; s < ntiles; ++s) {
            if (s + 1 < ntiles) L_STORE((s + 1) & 1);
            if (s + 2 < ntiles) G_LOAD(s + 2);
            const int buf = s & 1;
            const LAS unsigned char* kb = lds + buf * KBUF + r32 * KS + (TB ? 0 : wsel * 128) + 16 * h;
            const LAS unsigned char* vb = lds + 2 * KBUF + buf * VBUF + r32 * VS + 16 * h;
            f32x16 p0, p1;
            { const bf16x8 k0 = *(const LAS bf16x8*)(kb), k1 = *(const LAS bf16x8*)(kb + 32 * KS); p0 = MFMA32(k0, qr[0], negm); p1 = MFMA32(k1, qr[0], negm); }
#pragma unroll
            for (int d0 = 1; d0 < 4; ++d0) { const bf16x8 k0 = *(const LAS bf16x8*)(kb + 32 * d0), k1 = *(const LAS bf16x8*)(kb + 32 * KS + 32 * d0);
                p0 = MFMA32(k0, qr[d0], p0); p1 = MFMA32(k1, qr[d0], p1); }
            if (TB && s < n1) {
                const int kp0 = 64 * (t1 + s) - qpos;
#pragma unroll
                for (int i = 0; i < 16; ++i) { const int d = kp0 + crow(i, h); if (d > 128 || d < -128) p0[i] = -1e30f; if (d + 32 > 128 || d + 32 < -128) p1[i] = -1e30f; }
            }
            float mx;
            { float ma = max3f(p0[0], p0[1], p0[2]), mb = max3f(p0[3], p0[4], p0[5]), mc = max3f(p1[0], p1[1], p1[2]), md = max3f(p1[3], p1[4], p1[5]);
              ma = max3f(ma, p0[6], p0[7]); mb = max3f(mb, p0[8], p0[9]); mc = max3f(mc, p1[6], p1[7]); md = max3f(md, p1[8], p1[9]);
              ma = max3f(ma, p0[10], p0[11]); mb = max3f(mb, p0[12], p0[13]); mc = max3f(mc, p1[10], p1[11]); md = max3f(md, p1[12], p1[13]);
              ma = max3f(ma, p0[14], p0[15]); mc = max3f(mc, p1[14], p1[15]);
              mx = fmaxf(max3f(ma, mb, mc), md); }
            mx = fmaxf(mx, __shfl_xor(mx, 32));
            if (!TB && s == 0) {
                m_ref = mx;
#pragma unroll
                for (int i = 0; i < 16; ++i) { negm[i] = -m_ref; p0[i] -= mx; p1[i] -= mx; }
            } else if (__builtin_expect(__any(mx > THR), 0)) {
                const float dl = fmaxf(mx, 0.f), f = __builtin_amdgcn_exp2f(-dl);
                m_ref += dl;
#pragma unroll
                for (int i = 0; i < 16; ++i) { negm[i] = -m_ref; p0[i] -= dl; p1[i] -= dl; }
                osum = osum * f;
#pragma unroll
                for (int blk = 0; blk < NB; ++blk) o[blk] = o[blk] * f;
            }
#pragma unroll
            for (int i = 0; i < 16; ++i) { p0[i] = __builtin_amdgcn_exp2f(p0[i]); p1[i] = __builtin_amdgcn_exp2f(p1[i]); }
            bf16x8 pa[4];
#pragma unroll
            for (int ks = 0; ks < 2; ++ks) {
                u32x4 w0, w1;
                w0.x = pk_bf16(p0[8 * ks + 0], p0[8 * ks + 1]); w0.y = pk_bf16(p0[8 * ks + 2], p0[8 * ks + 3]); w0.z = pk_bf16(p0[8 * ks + 4], p0[8 * ks + 5]); w0.w = pk_bf16(p0[8 * ks + 6], p0[8 * ks + 7]);
                w1.x = pk_bf16(p1[8 * ks + 0], p1[8 * ks + 1]); w1.y = pk_bf16(p1[8 * ks + 2], p1[8 * ks + 3]); w1.z = pk_bf16(p1[8 * ks + 4], p1[8 * ks + 5]); w1.w = pk_bf16(p1[8 * ks + 6], p1[8 * ks + 7]);
                pa[ks] = __builtin_bit_cast(bf16x8, w0); pa[2 + ks] = __builtin_bit_cast(bf16x8, w1);
            }
#pragma unroll
            for (int ks = 0; ks < 4; ++ks)
#pragma unroll
                for (int blk = 0; blk < NB; ++blk) {
                    const bf16x8 vf = *(const LAS bf16x8*)(vb + blk * 32 * VS + 32 * ks);
                    o[blk] = MFMA32(vf, pa[ks], o[blk]);
                }
#pragma unroll
            for (int ks = 0; ks < 4; ++ks) osum = MFMA32(ones8, pa[ks], osum);
            __syncthreads();
        }
        const float inv = 1.0f / osum[0];
#pragma unroll
        for (int blk = 0; blk < NB; ++blk)
#pragma unroll
            for (int i = 0; i < 16; ++i) o[blk][i] *= inv;
        if (!TB) {
            LAS float* xch = (LAS float*)lds + (size_t)wq * 64 * 64 + lane;
            if (wsel == 1) {
#pragma unroll
                for (int blk = 0; blk < NB; ++blk)
#pragma unroll
                    for (int i = 0; i < 16; ++i) xch[(blk * 16 + i) * 64] = o[blk][i];
            }
            __syncthreads();
            if (wsel == 0) {
                float ss = 0.f;
#pragma unroll
                for (int blk = 0; blk < NB; ++blk)
#pragma unroll
                    for (int i = 0; i < 16; ++i) { const float v = o[blk][i] - lam * xch[(blk * 16 + i) * 64]; o[blk][i] = v; ss += v * v; }
                ss += __shfl_xor(ss, 32);
                const float rn = 0.8f / sqrtf(ss * (1.0f / 128.0f) + 1e-6f);
                bf16_t* op = O + (size_t)qrow * DM + head * 128 + 8 * h;
                f32x4 sgv[NB][4];
#pragma unroll
                for (int blk = 0; blk < NB; ++blk)
#pragma unroll
                    for (int g = 0; g < 4; ++g) sgv[blk][g] = *(const f32x4*)(subln + 32 * blk + 8 * g + 4 * h);
#pragma unroll
                for (int blk = 0; blk < NB; ++blk)
#pragma unroll
                    for (int gp = 0; gp < 2; ++gp) { u32x2 w[2];
#pragma unroll
                        for (int e = 0; e < 2; ++e) { const int g = 2 * gp + e; const f32x4 sg = sgv[blk][g];
                            w[e].x = pk_bf16(o[blk][4 * g] * rn * sg[0], o[blk][4 * g + 1] * rn * sg[1]); w[e].y = pk_bf16(o[blk][4 * g + 2] * rn * sg[2], o[blk][4 * g + 3] * rn * sg[3]); }
                        const auto rx = __builtin_amdgcn_permlane32_swap(w[0].x, w[1].x, false, false), ry = __builtin_amdgcn_permlane32_swap(w[0].y, w[1].y, false, false);
                        *(u32x4*)(op + 32 * blk + 16 * gp) = (u32x4){rx[0], ry[0], rx[1], ry[1]}; }
            }
            __syncthreads();
        } else {
            bf16_t* op = O + (size_t)qrow * DM + head * 64 + 8 * h;
#pragma unroll
            for (int blk = 0; blk < NB; ++blk)
#pragma unroll
                for (int gp = 0; gp < 2; ++gp) { u32x2 w[2];
#pragma unroll
                    for (int e = 0; e < 2; ++e) { const int g = 2 * gp + e; w[e].x = pk_bf16(o[blk][4 * g], o[blk][4 * g + 1]); w[e].y = pk_bf16(o[blk][4 * g + 2], o[blk][4 * g + 3]); }
                    const auto rx = __builtin_amdgcn_permlane32_swap(w[0].x, w[1].x, false, false), ry = __builtin_amdgcn_permlane32_swap(w[0].y, w[1].y, false, false);
                    *(u32x4*)(op + 32 * blk + 16 * gp) = (u32x4){rx[0], ry[0], rx[1], ry[1]}; }
        }
#undef TILE_OF
#undef G_LOAD
#undef L_STORE
    }
}

struct Params { const float* in[21]; float* out; unsigned char* ws; };
typedef const __attribute__((address_space(4))) Params* KargPtr;
#define KLOAD() ({ KargPtr kp_ = (KargPtr)__builtin_amdgcn_kernarg_segment_ptr(); asm volatile("" : "+s"(kp_)); kp_; })
__global__ void __launch_bounds__(NTHREADS, 2) fwd_megakernel(Params Punused) {
    extern __shared__ __attribute__((aligned(16))) unsigned char lds_raw[];
    LAS unsigned char* lds = (LAS unsigned char*)lds_raw;
    { volatile LAS unsigned* misc = (volatile LAS unsigned*)(lds + LDS_MISC); if (threadIdx.x < 16) misc[threadIdx.x] = 0u; }
    __syncthreads();
    const XcdBarrier bar = xcd_barrier_post((unsigned*)(((KargPtr)__builtin_amdgcn_kernarg_segment_ptr())->ws + WS_BAR), (volatile LAS unsigned*)(lds + LDS_MISC));

    {
        KargPtr P = KLOAD();
        int tid_o = threadIdx.x; asm volatile("" : "+v"(tid_o));
        const int lane = tid_o & 63, wave = __builtin_amdgcn_readfirstlane(tid_o >> 6);
        const int gw = blockIdx.x * NWAVES + wave, ngw = gridDim.x * NWAVES;
        unsigned char* ws = P->ws; float* modp = (float*)(ws + WS_MODP);
        { const f32x4* cin = (const f32x4*)P->in[2]; f32x4* xc = (f32x4*)(ws + WS_XC);
          for (int i = blockIdx.x * NTHREADS + tid_o; i < NCTX * DM / 4; i += gridDim.x * NTHREADS) xc[i] = cin[i]; }
        LAS float* scr = (LAS float*)(lds + wave * 16384);
        constexpr int I_WI = 16 * 176, I_WO = 44 * 32, I_QA = 16 * 96, I_O = 16 * 32, I_QB = 16 * 48, I_MOD = KC_MOD * 72;
        constexpr int NITEMS = 4 * (I_WI + I_WO) + I_QA + I_O + I_QB + I_O + I_MOD;
        for (int it = gw; it < NITEMS; it += ngw) {
            int r = it;
            if (r < I_MOD) { mod_item(P->in[1], P->in[3], P->in[4], modp, scr, r, lane); continue; } r -= I_MOD;
            constexpr int PL = 2 * (I_WI + I_WO);
            if (r < 2 * PL) {
                const int l = r / PL; r -= l * PL;
                unsigned char* wb = ws + WS_FFN0 + l * FFN_L_B;
                if (r < I_WI) { transpose_item(P->in[6] + (size_t)l * DM * 2 * DFF, DM, 2 * DFF, (bf16_t*)wb, 1, scr, r, lane); continue; } r -= I_WI;
                if (r < I_WO) { transpose_item(P->in[7] + (size_t)l * DFF * DM, DFF, DM, (bf16_t*)(wb + WI_B), 0, scr, r, lane); continue; } r -= I_WO;
                if (r < I_WI) { transpose_item(P->in[8] + (size_t)l * DM * 2 * DFF, DM, 2 * DFF, (bf16_t*)(wb + WI_B + WO_B), 1, scr, r, lane); continue; } r -= I_WI;
                transpose_item(P->in[9] + (size_t)l * DFF * DM, DFF, DM, (bf16_t*)(wb + 2 * WI_B + WO_B), 0, scr, r, lane); continue;
            }
            r -= 2 * PL;
            if (r < I_QA) { transpose_item(P->in[10], DM, 3072, (bf16_t*)(ws + WS_QKVA), 2, scr, r, lane); continue; } r -= I_QA;
            if (r < I_O) { transpose_item(P->in[11], DM, DM, (bf16_t*)(ws + WS_WOA), 0, scr, r, lane); continue; } r -= I_O;
            if (r < I_QB) { transpose_item(P->in[16], DM, 1536, (bf16_t*)(ws + WS_QKVB), 2, scr, r, lane); continue; } r -= I_QB;
            transpose_item(P->in[17], DM, DM, (bf16_t*)(ws + WS_WOB), 0, scr, r, lane);
        }
    }
    xcd_barrier(bar);
    {
        KargPtr P = KLOAD();
        float* mod = (float*)(P->ws + WS_MOD); const float* modp = (const float*)(P->ws + WS_MODP); const float* bias = P->in[5];
        for (int i = blockIdx.x * NTHREADS + threadIdx.x; i < 5 * MODP / 4; i += gridDim.x * NTHREADS) {
            const int r = i / (MODP / 4), n = (i % (MODP / 4)) * 4;
            f32x4 a = *(const f32x4*)(bias + n);
#pragma unroll
            for (int kc = 0; kc < KC_MOD; ++kc) a += *(const f32x4*)(modp + ((size_t)kc * 5 + r) * MODP + n);
            *(f32x4*)(mod + (size_t)r * MODP + n) = a;
        }
    }
    xcd_barrier(bar);

#pragma unroll 1
    for (int st = 0; st < 20; ++st) {
        KargPtr P = KLOAD();
        const int G = gridDim.x, bid = blockIdx.x;
        const int layer = st / 10, k = st % 10;
        const bool first = (layer == 0);
        const int mrows = (!first && k >= 6) ? NLAT : MROWS;
        unsigned char* ws = P->ws;
        const float* modl = (const float*)(ws + WS_MOD) + layer * 9216;
        float* XC = (float*)(ws + WS_XC); float* XL = P->out;
        bf16_t* H = (bf16_t*)(ws + WS_H); bf16_t* BIG = (bf16_t*)(ws + WS_BIG); bf16_t* VT = (bf16_t*)(ws + WS_BIG + WS_VT_OFF);
        unsigned char* wb = ws + WS_FFN0 + layer * FFN_L_B;
        const bool from_in = first && k <= 2;
        const float* xsl = from_in ? P->in[0] : XL; const float* xsc = XC;
        if (k == 0 || k == 3 || k == 7) {
            const int sub = (k == 0) ? 0 : (k == 3) ? 1 : 2;
            int tid_o = threadIdx.x; asm volatile("" : "+v"(tid_o));
            const int lane = tid_o & 63, wave = __builtin_amdgcn_readfirstlane(tid_o >> 6);
            const int nsplit = (st == 0) ? 0 : (k == 7 ? 4 : 8);
            norm_phase(xsl, XC, (const float*)(ws + WS_PART), nsplit, H, modl + 3 * sub * DM, mrows, bid * NWAVES + wave, G * NWAVES, lane);
        } else if (k == 1 || k == 8) {
            const bf16_t* wi = (const bf16_t*)(wb + (k == 1 ? 0 : WI_B + WO_B));
            pg8::Gemm g{H, wi, mrows, 2 * DFF, DM}; pg8::StaticOrder S; S.init(mrows, 2 * DFF, G, bid);
            pg8::EpiSwiglu E{BIG};
            pg8::gemm_phase<pg8::EpiSwiglu, pg8::StaticOrder, false, true>(lds, g, S, E);
        } else if (k == 2 || k == 6 || k == 9) {
            const bf16_t* A; const bf16_t* Bt; int K; float coef; int j;
            if (k == 2) { A = BIG; Bt = (const bf16_t*)(wb + WI_B); K = DFF; coef = 0.5f; j = 2; }
            else if (k == 9) { A = BIG; Bt = (const bf16_t*)(wb + 2 * WI_B + WO_B); K = DFF; coef = 0.5f; j = 8; }
            else { A = H; Bt = (const bf16_t*)(ws + (first ? WS_WOA : WS_WOB)); K = DM; coef = 1.0f; j = 5; }
            pg8::Gemm g{A, Bt, mrows, DM, K}; pg8::SplitOrder S; S.init(DM, G, bid, K, mrows == MROWS);
            pg8::EpiResid E{xsl, xsc, XL, XC, modl + j * DM, (float*)(ws + WS_PART), coef};
            pg8::gemm_phase<pg8::EpiResid, pg8::SplitOrder, true, true>(lds, g, S, E);
        } else if (k == 4) {
            const int N = first ? 3072 : 1536;
            pg8::Gemm g{H, (const bf16_t*)(ws + (first ? WS_QKVA : WS_QKVB)), mrows, N, DM}; pg8::StaticOrder S; S.init(mrows, N, G, bid);
            pg8::EpiQKV E{BIG, first ? 2048 : 1280, VT, 4, first ? 8 : 5, first ? 1024 : 256, first ? P->in[12] : P->in[18], first ? P->in[13] : P->in[19], 0.125f * 1.4426950408889634f};
            pg8::gemm_phase<pg8::EpiQKV, pg8::StaticOrder, true, true>(lds, g, S, E);
        } else {
            if (first) attn_phase<false>(lds, BIG, VT, H, P->in[14], P->in[15], nullptr, G, bid);
            else attn_phase<true>(lds, BIG, VT, H, nullptr, nullptr, P->in[20], G, bid);
        }
        if (st != 19) xcd_barrier(bar);
    }
}

extern "C" void kernel_launch(void* const* d_in, const int* in_sizes, int n_in, void* d_out, int out_size, void* d_ws, size_t ws_size, hipStream_t stream) {
    static int grid_blocks = 0;
    if (grid_blocks == 0) {
        if (n_in != 21 || ws_size < WS_END) { fprintf(stderr, "kernel_launch: unexpected n_in %d / ws %zu\n", n_in, ws_size); grid_blocks = -1; return; }
        int dev = 0, cus = 0, per_cu = 0;
        hipGetDevice(&dev);
        hipDeviceGetAttribute(&cus, hipDeviceAttributeMultiprocessorCount, dev);
        hipFuncSetAttribute((const void*)fwd_megakernel, hipFuncAttributeMaxDynamicSharedMemorySize, LDS_BYTES);
        hipOccupancyMaxActiveBlocksPerMultiprocessor(&per_cu, (const void*)fwd_megakernel, NTHREADS, LDS_BYTES);
        if (per_cu < 1) { fprintf(stderr, "kernel_launch: occupancy query says %d blocks per CU\n", per_cu); per_cu = 1; }
        if (per_cu > 1) per_cu = 1;
        grid_blocks = cus * per_cu;
    }
    if (grid_blocks < 0) return;
    if (hipMemsetAsync((char*)d_ws + WS_BAR, 0, BAR_ZERO_BYTES, stream) != hipSuccess) { fprintf(stderr, "kernel_launch: memset of barrier words failed\n"); return; }
    Params p{};
    for (int i = 0; i < 21; ++i) p.in[i] = (const float*)d_in[i];
    p.out = (float*)d_out; p.ws = (unsigned char*)d_ws;
    void* args[] = {&p};
    hipError_t e = hipLaunchCooperativeKernel((const void*)fwd_megakernel, dim3(grid_blocks), dim3(NTHREADS), args, LDS_BYTES, stream);
    if (e != hipSuccess) fprintf(stderr, "cooperative launch failed: %s (grid %d)\n", hipGetErrorString(e), grid_blocks);
}
```

```cpp
#include <hip/hip_runtime.h>
#include <cstdio>
#include <cstdint>
namespace pg8 {
#define PG8_LAS __attribute__((address_space(3)))
typedef unsigned short bf16_t;
typedef short bf16x8 __attribute__((ext_vector_type(8)));
typedef float f32x4 __attribute__((ext_vector_type(4)));
typedef unsigned u32x4 __attribute__((ext_vector_type(4)));
constexpr int BM = 256, BK = 64, HALF = 128, HTB = HALF * BK * 2  , STAGE_BYTES = 8 * HTB, NXCD = 8, WGM = 4;

__host__ __device__ __forceinline__ int lds_byte(int r, int c) { const int st = (r >> 4) * 2 + (c >> 5), rr = r & 15, cc = c & 31, ob = rr * 64 + cc * 2; return st * 1024 + (ob ^ (((ob >> 9) & 1) << 5)); }
__host__ __device__ __forceinline__ void stage_rc(int b, int& R, int& C) { const int st = b / 1024, sb = b % 1024, swz = sb ^ (((sb >> 9) & 1) << 5); R = (st >> 1) * 16 + swz / 64; C = (st & 1) * 32 + (swz % 64) / 2; }
__host__ __device__ __forceinline__ int perm32(int rho) { const int n = rho >> 4, i = rho & 15; return 8 * (i >> 2) + 4 * n + (i & 3); }

struct Unit { int pm, pn, k0, nt, sp; };
struct Gemm { const bf16_t* A; const bf16_t* Bt; int M, N, K; };

struct StaticOrder {
    int nM, nN, nwg, G, c;
    __host__ __device__ void init(int M, int N, int G_, int c_) { nM = M / BM; nN = N / BM; nwg = nM * nN; G = G_; c = c_; }
    __host__ __device__ bool next(int i, Unit& u) const {
        const long L = (long)i * G + c; if (L >= nwg) return false;
        int wgid = (int)L; { const int q = nwg / NXCD, r = nwg % NXCD, xcd = wgid % NXCD, off = wgid / NXCD; wgid = (xcd < r ? xcd * (q + 1) : r * (q + 1) + (xcd - r) * q) + off; }
        const int nig = WGM * nN, gid = wgid / nig, fm = gid * WGM, gsz = (nM - fm) < WGM ? (nM - fm) : WGM;
        u.pm = fm + ((wgid % nig) % gsz); u.pn = (wgid % nig) / gsz; u.k0 = 0; u.nt = 0; u.sp = 0; return true;
    }
    __device__ __forceinline__ void a_ready(const Unit&) const {}
    __device__ __forceinline__ void done(const Unit&) const {}
};

struct SplitOrder {
    StaticOrder base; int nlat, S, q, e, nsplit, G, c;
    __host__ __device__ void init(int N, int G_, int c_, int K, bool with_ctx) { base.init(16384, N, G_, c_); nlat = base.nwg; const int ntot = K / BK; S = ntot / 4 < 8 ? ntot / 4 : 8;
        q = (ntot / S) & ~1; e = (ntot - q * S) / 2; nsplit = with_ctx ? 16 * S : 0; G = G_; c = c_; }
    __host__ __device__ bool next(int i, Unit& u) const {
        const long L = (long)i * G + c;
        Unit a; a.pm = 0; a.pn = 0; a.k0 = 0; a.nt = 0; a.sp = 0; const bool okA = base.next(i, a);
        const long jl = L - nlat; const bool okB = (jl >= 0) && (jl < nsplit); const int j = okB ? (int)jl : 0;
        const int cu = j / S, sp = j % S;
        u.pm = okA ? a.pm : 64 + (cu >> 2); u.pn = okA ? a.pn : (cu & 3); u.sp = okA ? 0 : sp;
        u.nt = okA ? 0 : (sp < e ? q + 2 : q); u.k0 = okA ? 0 : (sp < e ? sp * (q + 2) : e * (q + 2) + (sp - e) * q) * BK;
        return okA || okB;
    }
    __device__ __forceinline__ void a_ready(const Unit&) const {}
    __device__ __forceinline__ void done(const Unit&) const {}
};
__device__ __forceinline__ unsigned cvt_pk_bf16(float lo, float hi) { unsigned r; asm volatile("v_cvt_pk_bf16_f32 %0, %1, %2" : "=v"(r) : "v"(lo), "v"(hi)); return r; }
typedef float f32x2 __attribute__((ext_vector_type(2)));
typedef unsigned u32x2v __attribute__((ext_vector_type(2)));
typedef float f32x2q __attribute__((ext_vector_type(2))); typedef __bf16 bf16x2q __attribute__((ext_vector_type(2)));
__device__ __forceinline__ unsigned pk_bf16(float lo, float hi) { f32x2q v = {lo, hi}; bf16x2q b = __builtin_convertvector(v, bf16x2q); return __builtin_bit_cast(unsigned, b); }
__device__ __forceinline__ float silu_f(float g) { return g * __builtin_amdgcn_rcpf(1.f + __builtin_amdgcn_exp2f(-1.4426950408889634f * g)); }
constexpr int NLAT = 16384, DM = 1024, DFF = 2816, MODP = 18432, TKV = 4352;

struct EpiSwiglu {
    static constexpr bool PERM = true, AFTER_DRAIN = false;
    bf16_t* O;
    __device__ __forceinline__ void operator()(const f32x4 (&acc)[2][2][4][2], const Unit& u, int wr, int wc, int fr, int fq) const {
        asm volatile("" : "+v"(fr), "+v"(fq));
        const int row0 = u.pm * BM + wr * 64 + fr, col0 = u.pn * 128 + wc * 32 + 8 * fq;
#pragma unroll
        for (int ai = 0; ai < 2; ++ai)
#pragma unroll
            for (int m = 0; m < 4; ++m) { bf16_t* rowp = O + (size_t)(row0 + ai * HALF + m * 16) * DFF + col0;
                const f32x4 g0 = acc[ai][0][m][0], g1 = acc[ai][0][m][1], v0 = acc[ai][1][m][0], v1 = acc[ai][1][m][1];
                u32x4 w; w.x = pk_bf16(silu_f(g0[0]) * v0[0], silu_f(g0[1]) * v0[1]); w.y = pk_bf16(silu_f(g0[2]) * v0[2], silu_f(g0[3]) * v0[3]);
                w.z = pk_bf16(silu_f(g1[0]) * v1[0], silu_f(g1[1]) * v1[1]); w.w = pk_bf16(silu_f(g1[2]) * v1[2], silu_f(g1[3]) * v1[3]);
                *(u32x4*)rowp = w; }
    }
};
struct EpiResid {
    static constexpr bool PERM = false, AFTER_DRAIN = false;
    const float* srcL; const float* srcC; float* dstL; float* dstC; const float* gate; float* part; float coef;
    __device__ __forceinline__ void operator()(const f32x4 (&acc)[2][2][4][2], const Unit& u, int wr, int wc, int fr, int fq) const {
        asm volatile("" : "+v"(fr), "+v"(fq));
        const bool isc = u.pm >= 64;
        const float* src = isc ? srcC + (size_t)(u.pm - 64) * BM * DM : srcL + (size_t)u.pm * BM * DM;
        float* dst = isc ? dstC + (size_t)(u.pm - 64) * BM * DM : dstL + (size_t)u.pm * BM * DM;
        const int modrow = isc ? 4 : (u.pm >> 4);
        const int col0 = u.pn * BM + wc * 32 + 4 * fq;
        const float* gp = gate + modrow * MODP + col0;
        f32x4 gv[2][2];
#pragma unroll
        for (int bj = 0; bj < 2; ++bj)
#pragma unroll
            for (int n = 0; n < 2; ++n) gv[bj][n] = *(const f32x4*)(gp + bj * HALF + n * 16) * coef;
#pragma unroll
        for (int ai = 0; ai < 2; ++ai)
#pragma unroll
            for (int m = 0; m < 4; ++m) { const size_t off = (size_t)(ai * HALF + wr * 64 + m * 16 + fr) * DM + col0;
#pragma unroll
                for (int bj = 0; bj < 2; ++bj)
#pragma unroll
                    for (int n = 0; n < 2; ++n) {
                        if (u.nt) {
                            *(f32x4*)(part + ((size_t)u.sp * 1024 + (u.pm - 64) * BM) * DM + off + bj * HALF + n * 16) = gv[bj][n] * acc[ai][bj][m][n];
                        } else { f32x4 xv = *(const f32x4*)(src + off + bj * HALF + n * 16); xv = xv + gv[bj][n] * acc[ai][bj][m][n]; *(f32x4*)(dst + off + bj * HALF + n * 16) = xv; } } }
    }
};
struct EpiQKV {
    static constexpr bool PERM = false, AFTER_DRAIN = false;
    bf16_t* QK; int qk_pitch; bf16_t* VT; int nq_tiles, nqk_tiles, vw; const float* qgain; const float* kgain; float qscale;
    __device__ __forceinline__ void operator()(const f32x4 (&acc)[2][2][4][2], const Unit& u, int wr, int wc, int fr, int fq) const {
        asm volatile("" : "+v"(fr), "+v"(fq));
        const int pn = u.pn;
        if (pn < nqk_tiles) {
            const bool isq = pn < nq_tiles; const float* gain = isq ? qgain : kgain; const float osc = isq ? qscale : 1.f;
            const int colbase = pn * BM + wc * 64 + 4 * fq;
            f32x4 gv[2][2];
#pragma unroll
            for (int bj = 0; bj < 2; ++bj)
#pragma unroll
                for (int n = 0; n < 2; ++n) gv[bj][n] = *(const f32x4*)(gain + 32 * bj + 16 * n + 4 * fq);
#pragma unroll
            for (int bj = 0; bj < 2; ++bj)
#pragma unroll
                for (int n = 0; n < 2; ++n) gv[bj][n] = gv[bj][n] * osc;
            const bool lat = u.pm < 64;
            f32x4 csr[2], snr[2], csc[4], snc[4];
            if (lat) {
                float invr[4];
#pragma unroll
                for (int i = 0; i < 4; ++i) invr[i] = __builtin_amdgcn_exp2f(-(float)(4 * fq + i) * 0.8304820237218406f) * 0.15915494309189535f;
#pragma unroll
                for (int ai = 0; ai < 2; ++ai) { const float cr = (float)(((u.pm * BM + ai * HALF + wr * 64) & 4095) >> 6);
#pragma unroll
                    for (int i = 0; i < 4; ++i) { csr[ai][i] = __builtin_amdgcn_cosf(cr * invr[i]); snr[ai][i] = __builtin_amdgcn_sinf(cr * invr[i]); } }
#pragma unroll
                for (int m = 0; m < 4; ++m) { const float cc = (float)(m * 16 + fr);
#pragma unroll
                    for (int i = 0; i < 4; ++i) { csc[m][i] = __builtin_amdgcn_cosf(cc * invr[i]); snc[m][i] = __builtin_amdgcn_sinf(cc * invr[i]); } }
            }
#pragma unroll
            for (int ai = 0; ai < 2; ++ai)
#pragma unroll
                for (int m = 0; m < 4; ++m) {
                    const int row = u.pm * BM + ai * HALF + wr * 64 + m * 16 + fr;
                    float ss = 0.f;
#pragma unroll
                    for (int bj = 0; bj < 2; ++bj)
#pragma unroll
                        for (int n = 0; n < 2; ++n) { const f32x4 v = acc[ai][bj][m][n]; ss += (v[0] * v[0] + v[1] * v[1]) + (v[2] * v[2] + v[3] * v[3]); }
                    ss += __shfl_xor(ss, 16); ss += __shfl_xor(ss, 32);
                    const float rs = __builtin_amdgcn_rsqf(ss * (1.0f / 64.0f) + 1e-6f);
                    f32x4 v[2][2];
#pragma unroll
                    for (int bj = 0; bj < 2; ++bj)
#pragma unroll
                        for (int n = 0; n < 2; ++n) v[bj][n] = acc[ai][bj][m][n] * rs * gv[bj][n];
                    if (lat) {
                        { const f32x4 x0 = v[0][0], x1 = v[0][1]; v[0][0] = x0 * csr[ai] - x1 * snr[ai]; v[0][1] = x1 * csr[ai] + x0 * snr[ai]; }
                        { const f32x4 x0 = v[1][0], x1 = v[1][1]; v[1][0] = x0 * csc[m] - x1 * snc[m]; v[1][1] = x1 * csc[m] + x0 * snc[m]; }
                    }
                    bf16_t* rowp = QK + (size_t)row * qk_pitch + colbase;
#pragma unroll
                    for (int bj = 0; bj < 2; ++bj)
#pragma unroll
                        for (int n = 0; n < 2; ++n) { const f32x4 o = v[bj][n]; u32x2v w; w.x = pk_bf16(o[0], o[1]); w.y = pk_bf16(o[2], o[3]); *(u32x2v*)(rowp + 32 * bj + 16 * n) = w; }
                }
        } else {
            const int vbase = (pn - nqk_tiles) * BM + wc * 64 + 4 * fq;
#pragma unroll
            for (int ai = 0; ai < 2; ++ai)
#pragma unroll
                for (int m = 0; m < 4; ++m) {
                    const int row = u.pm * BM + ai * HALF + wr * 64 + m * 16 + fr;
                    int b, tk; if (row < NLAT) { b = row >> 12; tk = row & 4095; } else { b = (row - NLAT) >> 8; tk = 4096 + ((row - NLAT) & 255); }
                    bf16_t* vp = VT + ((size_t)b * vw + vbase) * TKV + tk;
#pragma unroll
                    for (int bj = 0; bj < 2; ++bj)
#pragma unroll
                        for (int n = 0; n < 2; ++n) { const f32x4 o = acc[ai][bj][m][n]; const unsigned w0 = pk_bf16(o[0], o[1]), w1 = pk_bf16(o[2], o[3]);
                            bf16_t* q = vp + (size_t)(32 * bj + 16 * n) * TKV;
                            q[0] = (bf16_t)(w0 & 0xffffu); q[TKV] = (bf16_t)(w0 >> 16); q[2 * TKV] = (bf16_t)(w1 & 0xffffu); q[3 * TKV] = (bf16_t)(w1 >> 16); }
                }
        }
    }
};
template <class Epi, class Sched, bool ALIGN_EPI = false, bool SP2 = false>
__device__ __forceinline__ void gemm_phase(PG8_LAS unsigned char* lds, const Gemm g, const Sched& S, const Epi& E) {
    int tid_o = threadIdx.x; asm volatile("" : "+v"(tid_o));
    const int tid = tid_o, wid = __builtin_amdgcn_readfirstlane(tid >> 6), lane = tid & 63, wr = wid >> 2, wc = wid & 3, fr = lane & 15, fq = lane >> 4;
    const int K = g.K, nt = K / BK;
    unsigned voffA[2], voffB[2];
#pragma unroll
    for (int i = 0; i < 2; ++i) { int R, C; stage_rc(tid * 16 + i * 8192, R, C); const int Rb = Epi::PERM ? ((R & ~31) + perm32(R & 31)) : R;
        voffA[i] = (unsigned)(R * K + C) * 2u; voffB[i] = (unsigned)(Rb * K + C) * 2u; }
    const size_t kstep = (size_t)(BK * 2);
    const size_t hstep = (size_t)HALF * K * 2;
    const size_t tstep = 2 * hstep;
    const unsigned ldsw = (unsigned)wid * 1024u;
    const int aoff = lds_byte(wr * 64 + fr, fq * 8), boff = lds_byte(wc * 32 + fr, fq * 8);
#define PG8_SA(b, h) (((b) * 2 + (h)) * HTB)
#define PG8_SB(b, h) ((4 + (b) * 2 + (h)) * HTB)
#define PG8_STAGE(bufoff, gbase, voff) do { _Pragma("unroll") for (int _i = 0; _i < 2; ++_i) \
        __builtin_amdgcn_global_load_lds((const unsigned*)((const char*)(gbase) + (voff)[_i]), (PG8_LAS unsigned*)(lds + (bufoff) + ldsw + _i * 8192), 16, 0, 0); } while (0)
#define PG8_LDA(dst, b, h) do { _Pragma("unroll") for (int m = 0; m < 4; ++m) _Pragma("unroll") for (int k = 0; k < 2; ++k) dst[m][k] = *(const PG8_LAS bf16x8*)(lds + PG8_SA(b, h) + aoff + m * 2048 + k * 1024); } while (0)
#define PG8_LDB(dst, b, h) do { _Pragma("unroll") for (int n = 0; n < 2; ++n) _Pragma("unroll") for (int k = 0; k < 2; ++k) dst[n][k] = *(const PG8_LAS bf16x8*)(lds + PG8_SB(b, h) + boff + n * 2048 + k * 1024); } while (0)
#define PG8_MMA(ai, bj, At, Bt) do { __builtin_amdgcn_s_setprio(1); _Pragma("unroll") for (int m = 0; m < 4; ++m) _Pragma("unroll") for (int n = 0; n < 2; ++n) _Pragma("unroll") for (int k = 0; k < 2; ++k) \
        acc[ai][bj][m][n] = __builtin_amdgcn_mfma_f32_16x16x32_bf16(Bt[n][k], At[m][k], acc[ai][bj][m][n], 0, 0, 0); __builtin_amdgcn_s_setprio(0); } while (0)
#define PG8_WAIT_V(n) asm volatile("s_waitcnt vmcnt(" #n ")" ::: "memory")
#define PG8_WAIT_L(n) asm volatile("s_waitcnt lgkmcnt(" #n ")" ::: "memory")
#define PG8_BAR __builtin_amdgcn_s_barrier()
#define PG8_SCHED __builtin_amdgcn_sched_barrier(0)
    Unit cur, nxt; int ui = 0;
    if (!S.next(0, cur)) return;
    f32x4 acc[2][2][4][2];
#pragma unroll
    for (int a = 0; a < 2; ++a)
#pragma unroll
        for (int b = 0; b < 2; ++b)
#pragma unroll
            for (int m = 0; m < 4; ++m)
#pragma unroll
                for (int n = 0; n < 2; ++n) acc[a][b][m][n] = (f32x4){0.f, 0.f, 0.f, 0.f};
    bf16x8 At[4][2], B0[2][2], B1[2][2];
    const char* cA = (const char*)g.A + (size_t)cur.pm * tstep + (size_t)cur.k0 * 2; const char* cB = (const char*)g.Bt + (size_t)cur.pn * tstep + (size_t)cur.k0 * 2;
    S.a_ready(cur);
    if constexpr (SP2) {
        PG8_STAGE(PG8_SB(0, 0), cB, voffB); PG8_STAGE(PG8_SB(0, 1), cB + hstep, voffB); PG8_STAGE(PG8_SA(0, 0), cA, voffA); PG8_STAGE(PG8_SA(0, 1), cA + hstep, voffA);
        if (wr == 1) PG8_BAR;
        PG8_WAIT_V(2); PG8_BAR;
        PG8_STAGE(PG8_SB(1, 0), cB + kstep, voffB); PG8_STAGE(PG8_SA(1, 0), cA + kstep, voffA); PG8_STAGE(PG8_SB(1, 1), cB + hstep + kstep, voffB);
        PG8_WAIT_V(6); PG8_BAR;
    } else {
        PG8_STAGE(PG8_SB(0, 0), cB, voffB); PG8_STAGE(PG8_SA(0, 0), cA, voffA); PG8_STAGE(PG8_SB(0, 1), cB + hstep, voffB); PG8_STAGE(PG8_SA(0, 1), cA + hstep, voffA);
        if (wr == 1) PG8_BAR;
        PG8_WAIT_V(4); PG8_BAR;
        PG8_STAGE(PG8_SB(1, 0), cB + kstep, voffB); PG8_STAGE(PG8_SA(1, 0), cA + kstep, voffA); PG8_STAGE(PG8_SB(1, 1), cB + hstep + kstep, voffB);
        PG8_WAIT_V(6); PG8_BAR;
    }
    for (;;) {
        const bool has_next = S.next(ui + 1, nxt);
        const char* nA = has_next ? (const char*)g.A + (size_t)nxt.pm * tstep + (size_t)nxt.k0 * 2 : cA; const char* nB = has_next ? (const char*)g.Bt + (size_t)nxt.pn * tstep + (size_t)nxt.k0 * 2 : cB;
        const int unt = cur.nt ? cur.nt : nt;
        for (int t = 0; t < unt; t += 2) {
            const bool last = (t == unt - 2);
            const char* a1 = cA + (size_t)(t + 1) * kstep;
            const char* a2 = last ? nA : cA + (size_t)(t + 2) * kstep; const char* b2 = last ? nB : cB + (size_t)(t + 2) * kstep;
            const char* a3 = a2 + kstep; const char* b3 = b2 + kstep;
            if (last && has_next) S.a_ready(nxt);
            if constexpr (SP2) {
            PG8_LDB(B0, 0, 0); PG8_LDB(B1, 0, 1); PG8_SCHED; PG8_LDA(At, 0, 0); PG8_STAGE(PG8_SA(1, 1), a1 + hstep, voffA);
            PG8_WAIT_V(8); PG8_WAIT_L(0); PG8_BAR; PG8_MMA(0, 0, At, B0); PG8_MMA(0, 1, At, B1); PG8_BAR; PG8_SCHED;
            PG8_LDA(At, 0, 1); PG8_STAGE(PG8_SB(0, 0), b2, voffB); PG8_STAGE(PG8_SB(0, 1), b2 + hstep, voffB); PG8_STAGE(PG8_SA(0, 0), a2, voffA);
            PG8_WAIT_V(8); PG8_WAIT_L(0); PG8_BAR; PG8_MMA(1, 0, At, B0); PG8_MMA(1, 1, At, B1); PG8_BAR; PG8_SCHED;
            PG8_LDB(B0, 1, 0); PG8_LDB(B1, 1, 1); PG8_SCHED; PG8_LDA(At, 1, 0); PG8_STAGE(PG8_SA(0, 1), a2 + hstep, voffA);
            PG8_WAIT_V(8); PG8_WAIT_L(0); PG8_BAR; PG8_MMA(0, 0, At, B0); PG8_MMA(0, 1, At, B1); PG8_BAR; PG8_SCHED;
            PG8_LDA(At, 1, 1); PG8_STAGE(PG8_SB(1, 0), b3, voffB); PG8_STAGE(PG8_SB(1, 1), b3 + hstep, voffB); PG8_STAGE(PG8_SA(1, 0), a3, voffA);
            PG8_WAIT_V(8); PG8_WAIT_L(0); PG8_BAR; PG8_MMA(1, 0, At, B0); PG8_MMA(1, 1, At, B1); PG8_BAR; PG8_SCHED;
            } else {
            PG8_LDB(B0, 0, 0); PG8_SCHED; PG8_LDA(At, 0, 0); PG8_STAGE(PG8_SA(1, 1), a1 + hstep, voffA);
            PG8_WAIT_L(8); PG8_BAR; PG8_WAIT_L(0); PG8_MMA(0, 0, At, B0); PG8_BAR; PG8_SCHED;
            PG8_LDB(B1, 0, 1); PG8_STAGE(PG8_SB(0, 0), b2, voffB);
            PG8_BAR; PG8_WAIT_L(0); PG8_MMA(0, 1, At, B1); PG8_BAR;
            PG8_LDA(At, 0, 1); PG8_STAGE(PG8_SA(0, 0), a2, voffA);
            PG8_BAR; PG8_WAIT_L(0); PG8_MMA(1, 0, At, B0); PG8_BAR; PG8_SCHED;
            PG8_STAGE(PG8_SB(0, 1), b2 + hstep, voffB);
            PG8_WAIT_V(6); PG8_BAR; PG8_MMA(1, 1, At, B1); PG8_BAR;
            PG8_LDB(B0, 1, 0); PG8_SCHED; PG8_LDA(At, 1, 0); PG8_STAGE(PG8_SA(0, 1), a2 + hstep, voffA);
            PG8_WAIT_L(8); PG8_BAR; PG8_WAIT_L(0); PG8_MMA(0, 0, At, B0); PG8_BAR; PG8_SCHED;
            PG8_LDB(B1, 1, 1); PG8_STAGE(PG8_SB(1, 0), b3, voffB);
            PG8_BAR; PG8_WAIT_L(0); PG8_MMA(0, 1, At, B1); PG8_BAR;
            PG8_LDA(At, 1, 1); PG8_STAGE(PG8_SA(1, 0), a3, voffA);
            PG8_BAR; PG8_WAIT_L(0); PG8_MMA(1, 0, At, B0); PG8_BAR; PG8_SCHED;
            PG8_STAGE(PG8_SB(1, 1), b3 + hstep, voffB);
            PG8_WAIT_V(6); PG8_BAR; PG8_MMA(1, 1, At, B1); PG8_BAR;
            }
        }
        if constexpr (ALIGN_EPI) { if (wr == 0) PG8_BAR; }
        if constexpr (!Epi::AFTER_DRAIN) { E(acc, cur, wr, wc, fr, fq); S.done(cur); }
        if (!has_next) break;
#pragma unroll
        for (int a = 0; a < 2; ++a)
#pragma unroll
            for (int b = 0; b < 2; ++b)
#pragma unroll
                for (int m = 0; m < 4; ++m)
#pragma unroll
                    for (int n = 0; n < 2; ++n) acc[a][b][m][n] = (f32x4){0.f, 0.f, 0.f, 0.f};
        cur = nxt; cA = nA; cB = nB; ++ui;
        if constexpr (ALIGN_EPI) { if (wr == 1) PG8_BAR; }
    }
    PG8_WAIT_V(0);
    if constexpr (!ALIGN_EPI) { if (wr == 0) PG8_BAR; }
    PG8_BAR;
    if constexpr (Epi::AFTER_DRAIN) { E.fused(acc, cur, wr, wc, fr, fq, lds, wid, lane); S.done(cur); }
#undef PG8_SA
#undef PG8_SB
#undef PG8_STAGE
#undef PG8_LDA
#undef PG8_LDB
#undef PG8_MMA
#undef PG8_WAIT_V
#undef PG8_WAIT_L
#undef PG8_BAR
#undef PG8_SCHED
}
}

#define LAS __attribute__((address_space(3)))
typedef unsigned short bf16_t;
typedef short bf16x8 __attribute__((ext_vector_type(8)));
typedef short s16x4 __attribute__((ext_vector_type(4)));
typedef float f32x4 __attribute__((ext_vector_type(4)));
typedef float f32x16 __attribute__((ext_vector_type(16)));
typedef unsigned u32x4 __attribute__((ext_vector_type(4)));
typedef unsigned u32x2 __attribute__((ext_vector_type(2)));
using pg8::pk_bf16;
constexpr int NWAVES = 8, NTHREADS = 512;
constexpr int NLAT = 16384, NCTX = 1024, MROWS = NLAT + NCTX, DM = 1024, DFF = 2816, MODP = 18432, TKV = 4352;
constexpr int LDS_MISC = 131072, LDS_BYTES = 131072 + 64;
constexpr size_t MiB = 1u << 20;
constexpr size_t WS_BAR = 0, BAR_ZERO_BYTES = 16384, WS_MOD = 65536, WS_MODP = 1 * MiB, WS_XC = 8 * MiB, WS_W = 12 * MiB;
constexpr size_t WI_B = (size_t)2 * DFF * DM * 2, WO_B = (size_t)DM * DFF * 2;
constexpr size_t WS_FFN0 = WS_W;
constexpr size_t FFN_L_B = 2 * (WI_B + WO_B);
constexpr size_t WS_QKVA = WS_FFN0 + 2 * FFN_L_B, WS_WOA = WS_QKVA + 6 * MiB, WS_QKVB = WS_WOA + 2 * MiB, WS_WOB = WS_QKVB + 3 * MiB;
constexpr size_t WS_H = WS_WOB + 2 * MiB + 1 * MiB;
constexpr size_t WS_BIG = WS_H + 34 * MiB;
constexpr size_t WS_VT_OFF = 68 * MiB;
constexpr size_t WS_PART = WS_BIG + 102 * MiB;
constexpr size_t WS_END = WS_PART + 32 * MiB;
static_assert(WS_END <= 272 * MiB, "ws map");
static_assert((size_t)MROWS * DFF * 2 <= 102 * MiB && (size_t)MROWS * 2048 * 2 <= WS_VT_OFF, "big region");
constexpr int KC_MOD = 16;

#define XB_TMO      128
#define XB_XCNT(j)  (256  + 64 * (j))
#define XB_XSUB(j)  (1280 + 64 * (j))
#define XB_XGEN(j)  (2304 + 64 * (j))
#define XB_TOP      3328
#define XB_TOPGEN   3392
#define XCD_BAR_WORDS 3456
#define XB_SPIN_CAP (1u << 18)

__device__ __forceinline__ unsigned xb_ld(unsigned* p)              { return __hip_atomic_load(p, __ATOMIC_RELAXED, __HIP_MEMORY_SCOPE_AGENT); }
__device__ __forceinline__ unsigned xb_add(unsigned* p, unsigned v) { return __hip_atomic_fetch_add(p, v, __ATOMIC_RELAXED, __HIP_MEMORY_SCOPE_AGENT); }
__device__ __forceinline__ unsigned xb_xcc_id() { return (unsigned)__builtin_amdgcn_s_getreg((3 << 11) | 20) & 0xFu; }
#define XB_SPIN(cond, bar) do { unsigned _sp = 0; while (cond) { __builtin_amdgcn_s_sleep(1); \
    if ((++_sp & 255u) == 0u) { if (xb_ld(&(bar)[XB_TMO])) break; if (_sp > XB_SPIN_CAP) { atomicAdd(&(bar)[XB_TMO], 1u); break; } } } } while (0)

struct XcdBarrier {
    unsigned* bar; unsigned x;
    volatile LAS unsigned* st;
};

__device__ __forceinline__ XcdBarrier xcd_barrier_post(unsigned* bar, volatile LAS unsigned* st) {
    XcdBarrier b; b.bar = bar; b.x = xb_xcc_id(); b.st = st;
    if (threadIdx.x == 0) (void)xb_add(&bar[XB_XCNT(b.x)], 1u);
    return b;
}
__device__ __forceinline__ void xcd_barrier_complete(unsigned* bar, unsigned x, unsigned& nloc, unsigned& nx) {
    const unsigned G = gridDim.x * gridDim.y * gridDim.z;
    unsigned sum, cnt, mine, sp = 0u;
    for (;;) {
        sum = 0u; cnt = 0u; mine = 0u;
#pragma unroll
        for (unsigned j = 0; j < 16; ++j) { const unsigned c = xb_ld(&bar[XB_XCNT(j)]); sum += c; cnt += (c > 0u) ? 1u : 0u; mine = (j == x) ? c : mine; }
        if (sum == G) break;
        __builtin_amdgcn_s_sleep(1);
        if ((++sp & 255u) == 0u) { if (xb_ld(&bar[XB_TMO])) break; if (sp > XB_SPIN_CAP) { atomicAdd(&bar[XB_TMO], 1u); break; } }
    }
    nloc = mine > 0u ? mine : 1u; nx = cnt > 0u ? cnt : 1u;
}

__device__ __forceinline__ void xcd_barrier(const XcdBarrier& b) {
    asm volatile("s_waitcnt vmcnt(0)" ::: "memory");
    __syncthreads();
    if (threadIdx.x == 0) {
        unsigned* bar = b.bar;
        __builtin_amdgcn_s_waitcnt(0);
        unsigned nloc = b.st[0], nx = b.st[1];
        if (nloc == 0u) { xcd_barrier_complete(bar, b.x, nloc, nx); b.st[0] = nloc; b.st[1] = nx; }
        const unsigned old = xb_add(&bar[XB_XSUB(b.x)], 1u);
        const unsigned gen = old / nloc;
        if (old + 1u == (gen + 1u) * nloc) {
            __builtin_amdgcn_fence(__ATOMIC_RELEASE, "agent");
            asm volatile("s_waitcnt vmcnt(0)" ::: "memory");
            const unsigned og = xb_add(&bar[XB_TOP], 1u);
            const unsigned tg = og / nx;
            if (og + 1u == (tg + 1u) * nx) xb_add(&bar[XB_TOPGEN], 1u);
            else XB_SPIN(xb_ld(&bar[XB_TOPGEN]) == tg, bar);
            __builtin_amdgcn_fence(__ATOMIC_ACQUIRE, "agent");
            xb_add(&bar[XB_XGEN(b.x)], 1u);
            asm volatile("s_waitcnt vmcnt(0)" ::: "memory");
        } else {
            XB_SPIN(xb_ld(&bar[XB_XGEN(b.x)]) == gen, bar);
            __builtin_amdgcn_fence(__ATOMIC_ACQUIRE, "agent");
            asm volatile("s_waitcnt vmcnt(0)" ::: "memory");
        }
    }
    __syncthreads();
}

__device__ __forceinline__ float wave_sum(float v) {
#pragma unroll
    for (int o = 1; o < 64; o <<= 1) v += __shfl_xor(v, o);
    return v;
}

__device__ __forceinline__ int srcblk(int kind, int nb) {
    if (kind == 1) { const int pn = nb >> 3, s = (nb >> 2) & 1, jb = nb & 3; return s * 88 + 4 * pn + jb; }
    if (kind == 2) { const int pn = nb >> 3, bj = (nb >> 2) & 1, wc = nb & 3; return 8 * pn + 2 * wc + bj; }
    return nb;
}
__device__ __forceinline__ void transpose_item(const float* W, int K, int N, bf16_t* WT, int kind, LAS float* scr, int item, int lane) {
    const int nblk = N / 32, kb = item / nblk, nb = item % nblk, k0 = 64 * kb, n0s = 32 * srcblk(kind, nb), n0d = 32 * nb;
    { float t_[32];
#pragma unroll
      for (int i = 0; i < 32; ++i) t_[i] = W[(size_t)(k0 + 2 * i + (lane >> 5)) * N + n0s + (lane & 31)];
#pragma unroll
      for (int i = 0; i < 32; ++i) scr[(2 * i + (lane >> 5)) * 33 + (lane & 31)] = t_[i]; }
    asm volatile("s_waitcnt lgkmcnt(0)" ::: "memory");
    const int c = lane & 7;
#pragma unroll
    for (int j = 0; j < 4; ++j) { const int n = (lane >> 3) + 8 * j; const LAS float* s = scr + (8 * c) * 33 + n;
        u32x4 o; o.x = pk_bf16(s[0 * 33], s[1 * 33]); o.y = pk_bf16(s[2 * 33], s[3 * 33]); o.z = pk_bf16(s[4 * 33], s[5 * 33]); o.w = pk_bf16(s[6 * 33], s[7 * 33]);
        *(u32x4*)(WT + (size_t)(n0d + n) * K + k0 + 8 * c) = o; }
    asm volatile("s_waitcnt lgkmcnt(0)" ::: "memory");
}
__device__ __forceinline__ void mod_item(const float* c, const float* cctx, const float* adaw, float* part, LAS float* scr, int item, int lane) {
    const int kc = item / 72, cc = item % 72, n0 = 256 * cc, layer = n0 / 9216, col = n0 % 9216, k0 = 64 * kc;
#pragma unroll
    for (int r = 0; r < 5; ++r) { const float v = (r < 4) ? c[r * DM + k0 + lane] : cctx[k0 + lane]; scr[r * 64 + lane] = pg8::silu_f(v); }
    asm volatile("s_waitcnt lgkmcnt(0)" ::: "memory");
    const float* wp = adaw + ((size_t)layer * DM + k0) * 9216 + col + 4 * lane;
    f32x4 a0 = {0, 0, 0, 0}, a1 = a0, a2 = a0, a3 = a0, a4 = a0;
#pragma unroll 16
    for (int kk = 0; kk < 64; ++kk) { const f32x4 w = *(const f32x4*)(wp + (size_t)kk * 9216);
        a0 += w * scr[kk]; a1 += w * scr[64 + kk]; a2 += w * scr[128 + kk]; a3 += w * scr[192 + kk]; a4 += w * scr[256 + kk]; }
    float* pp = part + (size_t)kc * 5 * MODP + n0 + 4 * lane;
    *(f32x4*)(pp) = a0; *(f32x4*)(pp + MODP) = a1; *(f32x4*)(pp + 2 * MODP) = a2; *(f32x4*)(pp + 3 * MODP) = a3; *(f32x4*)(pp + 4 * MODP) = a4;
    asm volatile("s_waitcnt lgkmcnt(0)" ::: "memory");
}

template <int NS> __device__ __forceinline__ void norm_fold(f32x4 (&v)[4], int crow_, float* xc, const float* part, int lane) {
#pragma unroll
    for (int j = 0; j < 4; ++j) { const float* pp = part + (size_t)crow_ * DM + 4 * lane + 256 * j; f32x4 t[NS];
#pragma unroll
        for (int sp = 0; sp < NS; ++sp) t[sp] = *(const f32x4*)(pp + (size_t)sp * NCTX * DM);
#pragma unroll
        for (int sp = 0; sp < NS; ++sp) v[j] += t[sp];
        *(f32x4*)(xc + (size_t)crow_ * DM + 4 * lane + 256 * j) = v[j]; }
}
__device__ __forceinline__ void norm_finish(const f32x4 (&v)[4], int row, bf16_t* H, const f32x4 (&s4)[4], const f32x4 (&h4)[4], int lane) {
    float ss = 0.f;
#pragma unroll
    for (int j = 0; j < 4; ++j) ss += (v[j][0] * v[j][0] + v[j][1] * v[j][1]) + (v[j][2] * v[j][2] + v[j][3] * v[j][3]);
    const float rstd = 1.0f / sqrtf(wave_sum(ss) * (1.0f / DM) + 1e-6f);
#pragma unroll
    for (int j = 0; j < 4; ++j) { const int col = 4 * lane + 256 * j;
        const f32x4 o = (v[j] * rstd) * (s4[j] + 1.0f) + h4[j]; u32x2 w; w.x = pk_bf16(o[0], o[1]); w.y = pk_bf16(o[2], o[3]); *(u32x2*)(H + (size_t)row * DM + col) = w; }
}
__device__ __forceinline__ void norm_phase(const float* xl, float* xc, const float* part, int nsplit, bf16_t* H, const float* modsh, int nrows, int gw, int ngw, int lane) {
    int row = gw;
    if (row >= nrows) return;
    f32x4 va[4], vb[4], s4[4], h4[4];
    {   const int rb = row + ngw; const bool hb = rb < nrows;
        const float* xa = (row < NLAT) ? xl + (size_t)row * DM : xc + (size_t)(row - NLAT) * DM;
        const float* xb = !hb ? xa : (rb < NLAT) ? xl + (size_t)rb * DM : xc + (size_t)(rb - NLAT) * DM;
        const int mra = (row < NLAT) ? (row >> 12) : 4;
#pragma unroll
        for (int j = 0; j < 4; ++j) va[j] = *(const f32x4*)(xa + 4 * lane + 256 * j);
#pragma unroll
        for (int j = 0; j < 4; ++j) vb[j] = *(const f32x4*)(xb + 4 * lane + 256 * j);
#pragma unroll
        for (int j = 0; j < 4; ++j) { h4[j] = *(const f32x4*)(modsh + mra * MODP + 4 * lane + 256 * j); s4[j] = *(const f32x4*)(modsh + mra * MODP + DM + 4 * lane + 256 * j); } }
    for (;;) {
        const int rb = row + ngw; const bool hb = rb < nrows;
        const int mra = (row < NLAT) ? (row >> 12) : 4, mrb = !hb ? mra : (rb < NLAT) ? (rb >> 12) : 4;
        const int nrow = row + 2 * ngw; const bool hn = nrow < nrows;
        const int prow = hn ? nrow : row; const int prb = prow + ngw; const bool phb = prb < nrows;
        const float* pxa = (prow < NLAT) ? xl + (size_t)prow * DM : xc + (size_t)(prow - NLAT) * DM;
        const float* pxb = !phb ? pxa : (prb < NLAT) ? xl + (size_t)prb * DM : xc + (size_t)(prb - NLAT) * DM;
        const int pmra = (prow < NLAT) ? (prow >> 12) : 4;
        f32x4 na[4], nb[4], ns4[4], nh4[4];
#pragma unroll
        for (int j = 0; j < 4; ++j) na[j] = *(const f32x4*)(pxa + 4 * lane + 256 * j);
#pragma unroll
        for (int j = 0; j < 4; ++j) nb[j] = *(const f32x4*)(pxb + 4 * lane + 256 * j);
#pragma unroll
        for (int j = 0; j < 4; ++j) { nh4[j] = *(const f32x4*)(modsh + pmra * MODP + 4 * lane + 256 * j); ns4[j] = *(const f32x4*)(modsh + pmra * MODP + DM + 4 * lane + 256 * j); }
        if (row >= NLAT && nsplit > 0) { if (nsplit == 8) norm_fold<8>(va, row - NLAT, xc, part, lane); else norm_fold<4>(va, row - NLAT, xc, part, lane); }
        if (hb && rb >= NLAT && nsplit > 0) { if (nsplit == 8) norm_fold<8>(vb, rb - NLAT, xc, part, lane); else norm_fold<4>(vb, rb - NLAT, xc, part, lane); }
        norm_finish(va, row, H, s4, h4, lane);
        if (hb) {
            if (mrb != mra) {
#pragma unroll
                for (int j = 0; j < 4; ++j) { h4[j] = *(const f32x4*)(modsh + mrb * MODP + 4 * lane + 256 * j); s4[j] = *(const f32x4*)(modsh + mrb * MODP + DM + 4 * lane + 256 * j); } }
            norm_finish(vb, rb, H, s4, h4, lane);
        }
        if (!hn) break;
        row = nrow;
#pragma unroll
        for (int j = 0; j < 4; ++j) { va[j] = na[j]; vb[j] = nb[j]; s4[j] = ns4[j]; h4[j] = nh4[j]; }
    }
}

__device__ __forceinline__ int crow(int i, int h) { return (i & 3) + 8 * (i >> 2) + 4 * h; }
#define MFMA32(a, b, c) __builtin_amdgcn_mfma_f32_32x32x16_bf16((a), (b), (c), 0, 0, 0)
__device__ __forceinline__ float max3f(float a, float b, float c) { return __builtin_fmaxf(__builtin_fmaxf(a, b), c); }
template <bool TB>
__device__ __forceinline__ void attn_phase(LAS unsigned char* lds, const bf16_t* QK, const bf16_t* VT, bf16_t* O, const float* lamvec, const float* subln, const float* sink, int nblocks, int bid) {
    constexpr int DV = TB ? 64 : 128, NB = DV / 32;
    constexpr int QKP = TB ? 1280 : 2048, VW = TB ? 256 : 1024;
    constexpr int KROWB = TB ? 128 : 256, KS = KROWB + 16, VS = 144;
    constexpr int KBUF = 64 * KS, VBUF = DV * VS;
    constexpr int NKC = KROWB / 128, NVC = DV / 64;
    constexpr int KCPR = KROWB / 16;
    static_assert(2 * KBUF + 2 * VBUF <= LDS_BYTES && (TB || 4 * 64 * 64 * 4 <= 2 * KBUF + 2 * VBUF), "attn lds");
    int tid_o = threadIdx.x; asm volatile("" : "+v"(tid_o));
    const int tid = tid_o, lane = tid & 63, wid = __builtin_amdgcn_readfirstlane(tid >> 6), r32 = lane & 31, h = lane >> 5;
    const int wq = wid & 3, wsel = wid >> 2;
    float lam = 0.f;
    if (!TB) { float a = lamvec[lane] * lamvec[64 + lane], b = lamvec[128 + lane] * lamvec[192 + lane]; a = wave_sum(a); b = wave_sum(b); lam = expf(a) - expf(b) + 0.2f; }
    const int nunits = TB ? 1024 : 1088;
    for (int u = bid; u < nunits; u += nblocks) {
        int b, head, qb, kvh = 0; bool isctx = false;
        if (!TB) {
            if (u < 1024) { const int bh = (u >> 8) * 8 + (u & 7); qb = (u & 255) >> 3; b = bh >> 3; head = bh & 7; }
            else { const int v = u - 1024; b = v >> 4; head = (v >> 1) & 7; qb = v & 1; isctx = true; }
        } else { b = u >> 8; qb = (u >> 3) & 31; kvh = (u >> 1) & 3; head = kvh * 4 + (u & 1) * 2 + wsel; }
        int t1, n1;
        if (!TB) { t1 = 0; n1 = isctx ? 0 : 64; } else { t1 = (2 * qb - 2 > 0) ? 2 * qb - 2 : 0; const int te = (2 * qb + 4 < 64) ? 2 * qb + 4 : 64; n1 = te - t1; }
        const int ntiles = n1 + 4;
        const int qpos = qb * 128 + 32 * wq + r32;
        const int qrow = isctx ? NLAT + b * 256 + qpos : b * 4096 + qpos;
        const int qcol = TB ? head * 64 : head * 128 + wsel * 64;
        bf16x8 qr[4];
        { const bf16_t* qp = QK + (size_t)qrow * QKP + qcol + 8 * h;
#pragma unroll
          for (int d0 = 0; d0 < 4; ++d0) qr[d0] = *(const bf16x8*)(qp + 16 * d0); }
        const bf16_t* kg = QK + 1024 + (TB ? kvh * 64 : head * 128);
        const bf16_t* vg = VT + ((size_t)b * VW + (TB ? kvh * 64 : head * 128)) * TKV;
        u32x4 kst[NKC], vst[NVC];
#define TILE_OF(s) (((s) < n1) ? t1 + (s) : 64 + (s) - n1)
#define G_LOAD(s) do { const int t_ = TILE_OF(s); const int krow_ = (t_ < 64) ? b * 4096 + 64 * t_ : NLAT + b * 256 + 64 * (t_ - 64); \
        _Pragma("unroll") for (int i_ = 0; i_ < NKC; ++i_) { const int c_ = tid + 512 * i_; kst[i_] = *(const u32x4*)(kg + (size_t)(krow_ + c_ / KCPR) * QKP + (c_ % KCPR) * 8); } \
        _Pragma("unroll") for (int i_ = 0; i_ < NVC; ++i_) { const int c_ = tid + 512 * i_; vst[i_] = *(const u32x4*)(vg + (size_t)(c_ >> 3) * TKV + 64 * t_ + (c_ & 7) * 8); } } while (0)
#define L_STORE(buf) do { LAS unsigned char* kb_ = lds + (buf) * KBUF; LAS unsigned char* vb_ = lds + 2 * KBUF + (buf) * VBUF; \
        _Pragma("unroll") for (int i_ = 0; i_ < NKC; ++i_) { const int c_ = tid + 512 * i_; *(LAS u32x4*)(kb_ + (c_ / KCPR) * KS + (c_ % KCPR) * 16) = kst[i_]; } \
        _Pragma("unroll") for (int i_ = 0; i_ < NVC; ++i_) { const int c_ = tid + 512 * i_; LAS unsigned char* p_ = vb_ + (c_ >> 3) * VS + ((c_ & 7) >> 1) * 32 + (c_ & 1) * 8; \
            *(LAS u32x2*)(p_) = (u32x2){vst[i_].x, vst[i_].y}; *(LAS u32x2*)(p_ + 16) = (u32x2){vst[i_].z, vst[i_].w}; } } while (0)
        constexpr float THR = 8.0f;
        float m_ref; f32x16 osum;
        { const float l0 = TB ? 1.f : 0.f;
#pragma unroll
          for (int i = 0; i < 16; ++i) osum[i] = l0; }
        if (TB) m_ref = sink[head] * 1.4426950408889634f; else m_ref = 0.f;
        const bf16x8 ones8 = (bf16x8){0x3F80, 0x3F80, 0x3F80, 0x3F80, 0x3F80, 0x3F80, 0x3F80, 0x3F80};
        f32x16 negm;
#pragma unroll
        for (int i = 0; i < 16; ++i) negm[i] = -m_ref;
        f32x16 o[NB];
#pragma unroll
        for (int blk = 0; blk < NB; ++blk)
#pragma unroll
            for (int i = 0; i < 16; ++i) o[blk][i] = 0.f;
        G_LOAD(0); L_STORE(0); G_LOAD(1); __syncthreads();
        for (int s = 0; s < ntiles; ++s) {
            if (s + 1 < ntiles) L_STORE((s + 1) & 1);
            if (s + 2 < ntiles) G_LOAD(s + 2);
            const int buf = s & 1;
            const LAS unsigned char* kb = lds + buf * KBUF + r32 * KS + (TB ? 0 : wsel * 128) + 16 * h;
            const LAS unsigned char* vb = lds + 2 * KBUF + buf * VBUF + r32 * VS + 16 * h;
            f32x16 p0, p1;
            { const bf16x8 k0 = *(const LAS bf16x8*)(kb), k1 = *(const LAS bf16x8*)(kb + 32 * KS); p0 = MFMA32(k0, qr[0], negm); p1 = MFMA32(k1, qr[0], negm); }
#pragma unroll
            for (int d0 = 1; d0 < 4; ++d0) { const bf16x8 k0 = *(const LAS bf16x8*)(kb + 32 * d0), k1 = *(const LAS bf16x8*)(kb + 32 * KS + 32 * d0);
                p0 = MFMA32(k0, qr[d0], p0); p1 = MFMA32(k1, qr[d0], p1); }
            if (TB && s < n1) {
                const int kp0 = 64 * (t1 + s) - qpos;
#pragma unroll
                for (int i = 0; i < 16; ++i) { const int d = kp0 + crow(i, h); if (d > 128 || d < -128) p0[i] = -1e30f; if (d + 32 > 128 || d + 32 < -128) p1[i] = -1e30f; }
            }
            float mx;
            { float ma = max3f(p0[0], p0[1], p0[2]), mb = max3f(p0[3], p0[4], p0[5]), mc = max3f(p1[0], p1[1], p1[2]), md = max3f(p1[3], p1[4], p1[5]);
              ma = max3f(ma, p0[6], p0[7]); mb = max3f(mb, p0[8], p0[9]); mc = max3f(mc, p1[6], p1[7]); md = max3f(md, p1[8], p1[9]);
              ma = max3f(ma, p0[10], p0[11]); mb = max3f(mb, p0[12], p0[13]); mc = max3f(mc, p1[10], p1[11]); md = max3f(md, p1[12], p1[13]);
              ma = max3f(ma, p0[14], p0[15]); mc = max3f(mc, p1[14], p1[15]);
              mx = fmaxf(max3f(ma, mb, mc), md); }
            mx = fmaxf(mx, __shfl_xor(mx, 32));
            if (!TB && s == 0) {
                m_ref = mx;
#pragma unroll
                for (int i = 0; i < 16; ++i) { negm[i] = -m_ref; p0[i] -= mx; p1[i] -= mx; }
            } else if (__builtin_expect(__any(mx > THR), 0)) {
                const float dl = fmaxf(mx, 0.f), f = __builtin_amdgcn_exp2f(-dl);
                m_ref += dl;
#pragma unroll
                for (int i = 0; i < 16; ++i) { negm[i] = -m_ref; p0[i] -= dl; p1[i] -= dl; }
                osum = osum * f;
#pragma unroll
                for (int blk = 0; blk < NB; ++blk) o[blk] = o[blk] * f;
            }
#pragma unroll
            for (int i = 0; i < 16; ++i) { p0[i] = __builtin_amdgcn_exp2f(p0[i]); p1[i] = __builtin_amdgcn_exp2f(p1[i]); }
            bf16x8 pa[4];
#pragma unroll
            for (int ks = 0; ks < 2; ++ks) {
                u32x4 w0, w1;
                w0.x = pk_bf16(p0[8 * ks + 0], p0[8 * ks + 1]); w0.y = pk_bf16(p0[8 * ks + 2], p0[8 * ks + 3]); w0.z = pk_bf16(p0[8 * ks + 4], p0[8 * ks + 5]); w0.w = pk_bf16(p0[8 * ks + 6], p0[8 * ks + 7]);
                w1.x = pk_bf16(p1[8 * ks + 0], p1[8 * ks + 1]); w1.y = pk_bf16(p1[8 * ks + 2], p1[8 * ks + 3]); w1.z = pk_bf16(p1[8 * ks + 4], p1[8 * ks + 5]); w1.w = pk_bf16(p1[8 * ks + 6], p1[8 * ks + 7]);
                pa[ks] = __builtin_bit_cast(bf16x8, w0); pa[2 + ks] = __builtin_bit_cast(bf16x8, w1);
            }
#pragma unroll
            for (int ks = 0; ks < 4; ++ks)
#pragma unroll
                for (int blk = 0; blk < NB; ++blk) {
                    const bf16x8 vf = *(const LAS bf16x8*)(vb + blk * 32 * VS + 32 * ks);
                    o[blk] = MFMA32(vf, pa[ks], o[blk]);
                }
#pragma unroll
            for (int ks = 0; ks < 4; ++ks) osum = MFMA32(ones8, pa[ks], osum);
            __syncthreads();
        }
        const float inv = 1.0f / osum[0];
#pragma unroll
        for (int blk = 0; blk < NB; ++blk)
#pragma unroll
            for (int i = 0; i < 16; ++i) o[blk][i] *= inv;
        if (!TB) {
            LAS float* xch = (LAS float*)lds + (size_t)wq * 64 * 64 + lane;
            if (wsel == 1) {
#pragma unroll
                for (int blk = 0; blk < NB; ++blk)
#pragma unroll
                    for (int i = 0; i < 16; ++i) xch[(blk * 16 + i) * 64] = o[blk][i];
            }
            __syncthreads();
            if (wsel == 0) {
                float ss = 0.f;
#pragma unroll
                for (int blk = 0; blk < NB; ++blk)
#pragma unroll
                    for (int i = 0; i < 16; ++i) { const float v = o[blk][i] - lam * xch[(blk * 16 + i) * 64]; o[blk][i] = v; ss += v * v; }
                ss += __shfl_xor(ss, 32);
                const float rn = 0.8f / sqrtf(ss * (1.0f / 128.0f) + 1e-6f);
                bf16_t* op = O + (size_t)qrow * DM + head * 128 + 8 * h;
#pragma unroll
                for (int blk = 0; blk < NB; ++blk)
#pragma unroll
                    for (int gp = 0; gp < 2; ++gp) { u32x2 w[2];
#pragma unroll
                        for (int e = 0; e < 2; ++e) { const int g = 2 * gp + e, dv = 32 * blk + 8 * g; const f32x4 sg = *(const f32x4*)(subln + dv + 4 * h);
                            w[e].x = pk_bf16(o[blk][4 * g] * rn * sg[0], o[blk][4 * g + 1] * rn * sg[1]); w[e].y = pk_bf16(o[blk][4 * g + 2] * rn * sg[2], o[blk][4 * g + 3] * rn * sg[3]); }
                        const auto rx = __builtin_amdgcn_permlane32_swap(w[0].x, w[1].x, false, false), ry = __builtin_amdgcn_permlane32_swap(w[0].y, w[1].y, false, false);
                        *(u32x4*)(op + 32 * blk + 16 * gp) = (u32x4){rx[0], ry[0], rx[1], ry[1]}; }
            }
            __syncthreads();
        } else {
            bf16_t* op = O + (size_t)qrow * DM + head * 64 + 8 * h;
#pragma unroll
            for (int blk = 0; blk < NB; ++blk)
#pragma unroll
                for (int gp = 0; gp < 2; ++gp) { u32x2 w[2];
#pragma unroll
                    for (int e = 0; e < 2; ++e) { const int g = 2 * gp + e; w[e].x = pk_bf16(o[blk][4 * g], o[blk][4 * g + 1]); w[e].y = pk_bf16(o[blk][4 * g + 2], o[blk][4 * g + 3]); }
                    const auto rx = __builtin_amdgcn_permlane32_swap(w[0].x, w[1].x, false, false), ry = __builtin_amdgcn_permlane32_swap(w[0].y, w[1].y, false, false);
                    *(u32x4*)(op + 32 * blk + 16 * gp) = (u32x4){rx[0], ry[0], rx[1], ry[1]}; }
        }
#undef TILE_OF
#undef G_LOAD
#undef L_STORE
    }
}

struct Params { const float* in[21]; float* out; unsigned char* ws; };
typedef const __attribute__((address_space(4))) Params* KargPtr;
#define KLOAD() ({ KargPtr kp_ = (KargPtr)__builtin_amdgcn_kernarg_segment_ptr(); asm volatile("" : "+s"(kp_)); kp_; })
__global__ void __launch_bounds__(NTHREADS, 2) fwd_megakernel(Params Punused) {
    extern __shared__ __attribute__((aligned(16))) unsigned char lds_raw[];
    LAS unsigned char* lds = (LAS unsigned char*)lds_raw;
    { volatile LAS unsigned* misc = (volatile LAS unsigned*)(lds + LDS_MISC); if (threadIdx.x < 16) misc[threadIdx.x] = 0u; }
    __syncthreads();
    const XcdBarrier bar = xcd_barrier_post((unsigned*)(((KargPtr)__builtin_amdgcn_kernarg_segment_ptr())->ws + WS_BAR), (volatile LAS unsigned*)(lds + LDS_MISC));

    {
        KargPtr P = KLOAD();
        int tid_o = threadIdx.x; asm volatile("" : "+v"(tid_o));
        const int lane = tid_o & 63, wave = __builtin_amdgcn_readfirstlane(tid_o >> 6);
        const int gw = blockIdx.x * NWAVES + wave, ngw = gridDim.x * NWAVES;
        unsigned char* ws = P->ws; float* modp = (float*)(ws + WS_MODP);
        { const f32x4* cin = (const f32x4*)P->in[2]; f32x4* xc = (f32x4*)(ws + WS_XC);
          for (int i = blockIdx.x * NTHREADS + tid_o; i < NCTX * DM / 4; i += gridDim.x * NTHREADS) xc[i] = cin[i]; }
        LAS float* scr = (LAS float*)(lds + wave * 16384);
        constexpr int I_WI = 16 * 176, I_WO = 44 * 32, I_QA = 16 * 96, I_O = 16 * 32, I_QB = 16 * 48, I_MOD = KC_MOD * 72;
        constexpr int NITEMS = 4 * (I_WI + I_WO) + I_QA + I_O + I_QB + I_O + I_MOD;
        for (int it = gw; it < NITEMS; it += ngw) {
            int r = it;
            if (r < I_MOD) { mod_item(P->in[1], P->in[3], P->in[4], modp, scr, r, lane); continue; } r -= I_MOD;
            constexpr int PL = 2 * (I_WI + I_WO);
            if (r < 2 * PL) {
                const int l = r / PL; r -= l * PL;
                unsigned char* wb = ws + WS_FFN0 + l * FFN_L_B;
                if (r < I_WI) { transpose_item(P->in[6] + (size_t)l * DM * 2 * DFF, DM, 2 * DFF, (bf16_t*)wb, 1, scr, r, lane); continue; } r -= I_WI;
                if (r < I_WO) { transpose_item(P->in[7] + (size_t)l * DFF * DM, DFF, DM, (bf16_t*)(wb + WI_B), 0, scr, r, lane); continue; } r -= I_WO;
                if (r < I_WI) { transpose_item(P->in[8] + (size_t)l * DM * 2 * DFF, DM, 2 * DFF, (bf16_t*)(wb + WI_B + WO_B), 1, scr, r, lane); continue; } r -= I_WI;
                transpose_item(P->in[9] + (size_t)l * DFF * DM, DFF, DM, (bf16_t*)(wb + 2 * WI_B + WO_B), 0, scr, r, lane); continue;
            }
            r -= 2 * PL;
            if (r < I_QA) { transpose_item(P->in[10], DM, 3072, (bf16_t*)(ws + WS_QKVA), 2, scr, r, lane); continue; } r -= I_QA;
            if (r < I_O) { transpose_item(P->in[11], DM, DM, (bf16_t*)(ws + WS_WOA), 0, scr, r, lane); continue; } r -= I_O;
            if (r < I_QB) { transpose_item(P->in[16], DM, 1536, (bf16_t*)(ws + WS_QKVB), 2, scr, r, lane); continue; } r -= I_QB;
            transpose_item(P->in[17], DM, DM, (bf16_t*)(ws + WS_WOB), 0, scr, r, lane);
        }
    }
    xcd_barrier(bar);
    {
        KargPtr P = KLOAD();
        float* mod = (float*)(P->ws + WS_MOD); const float* modp = (const float*)(P->ws + WS_MODP); const float* bias = P->in[5];
        for (int i = blockIdx.x * NTHREADS + threadIdx.x; i < 5 * MODP / 4; i += gridDim.x * NTHREADS) {
            const int r = i / (MODP / 4), n = (i % (MODP / 4)) * 4;
            f32x4 a = *(const f32x4*)(bias + n);
#pragma unroll
            for (int kc = 0; kc < KC_MOD; ++kc) a += *(const f32x4*)(modp + ((size_t)kc * 5 + r) * MODP + n);
            *(f32x4*)(mod + (size_t)r * MODP + n) = a;
        }
    }
    xcd_barrier(bar);

#pragma unroll 1
    for (int st = 0; st < 20; ++st) {
        KargPtr P = KLOAD();
        const int G = gridDim.x, bid = blockIdx.x;
        const int layer = st / 10, k = st % 10;
        const bool first = (layer == 0);
        const int mrows = (!first && k >= 6) ? NLAT : MROWS;
        unsigned char* ws = P->ws;
        const float* modl = (const float*)(ws + WS_MOD) + layer * 9216;
        float* XC = (float*)(ws + WS_XC); float* XL = P->out;
        bf16_t* H = (bf16_t*)(ws + WS_H); bf16_t* BIG = (bf16_t*)(ws + WS_BIG); bf16_t* VT = (bf16_t*)(ws + WS_BIG + WS_VT_OFF);
        unsigned char* wb = ws + WS_FFN0 + layer * FFN_L_B;
        const bool from_in = first && k <= 2;
        const float* xsl = from_in ? P->in[0] : XL; const float* xsc = XC;
        if (k == 0 || k == 3 || k == 7) {
            const int sub = (k == 0) ? 0 : (k == 3) ? 1 : 2;
            int tid_o = threadIdx.x; asm volatile("" : "+v"(tid_o));
            const int lane = tid_o & 63, wave = __builtin_amdgcn_readfirstlane(tid_o >> 6);
            const int nsplit = (st == 0) ? 0 : (k == 7 ? 4 : 8);
            norm_phase(xsl, XC, (const float*)(ws + WS_PART), nsplit, H, modl + 3 * sub * DM, mrows, bid * NWAVES + wave, G * NWAVES, lane);
        } else if (k == 1 || k == 8) {
            const bf16_t* wi = (const bf16_t*)(wb + (k == 1 ? 0 : WI_B + WO_B));
            pg8::Gemm g{H, wi, mrows, 2 * DFF, DM}; pg8::StaticOrder S; S.init(mrows, 2 * DFF, G, bid);
            pg8::EpiSwiglu E{BIG};
            pg8::gemm_phase<pg8::EpiSwiglu, pg8::StaticOrder, false, true>(lds, g, S, E);
        } else if (k == 2 || k == 6 || k == 9) {
            const bf16_t* A; const bf16_t* Bt; int K; float coef; int j;
            if (k == 2) { A = BIG; Bt = (const bf16_t*)(wb + WI_B); K = DFF; coef = 0.5f; j = 2; }
            else if (k == 9) { A = BIG; Bt = (const bf16_t*)(wb + 2 * WI_B + WO_B); K = DFF; coef = 0.5f; j = 8; }
            else { A = H; Bt = (const bf16_t*)(ws + (first ? WS_WOA : WS_WOB)); K = DM; coef = 1.0f; j = 5; }
            pg8::Gemm g{A, Bt, mrows, DM, K}; pg8::SplitOrder S; S.init(DM, G, bid, K, mrows == MROWS);
            pg8::EpiResid E{xsl, xsc, XL, XC, modl + j * DM, (float*)(ws + WS_PART), coef};
            pg8::gemm_phase<pg8::EpiResid, pg8::SplitOrder, true, true>(lds, g, S, E);
        } else if (k == 4) {
            const int N = first ? 3072 : 1536;
            pg8::Gemm g{H, (const bf16_t*)(ws + (first ? WS_QKVA : WS_QKVB)), mrows, N, DM}; pg8::StaticOrder S; S.init(mrows, N, G, bid);
            pg8::EpiQKV E{BIG, first ? 2048 : 1280, VT, 4, first ? 8 : 5, first ? 1024 : 256, first ? P->in[12] : P->in[18], first ? P->in[13] : P->in[19], 0.125f * 1.4426950408889634f};
            pg8::gemm_phase<pg8::EpiQKV, pg8::StaticOrder, true, true>(lds, g, S, E);
        } else {
            if (first) attn_phase<false>(lds, BIG, VT, H, P->in[14], P->in[15], nullptr, G, bid);
            else attn_phase<true>(lds, BIG, VT, H, nullptr, nullptr, P->in[20], G, bid);
        }
        if (st != 19) xcd_barrier(bar);
    }
}

extern "C" void kernel_launch(void* const* d_in, const int* in_sizes, int n_in, void* d_out, int out_size, void* d_ws, size_t ws_size, hipStream_t stream) {
    static int grid_blocks = 0;
    if (grid_blocks == 0) {
        if (n_in != 21 || ws_size < WS_END) { fprintf(stderr, "kernel_launch: unexpected n_in %d / ws %zu\n", n_in, ws_size); grid_blocks = -1; return; }
        int dev = 0, cus = 0, per_cu = 0;
        hipGetDevice(&dev);
        hipDeviceGetAttribute(&cus, hipDeviceAttributeMultiprocessorCount, dev);
        hipFuncSetAttribute((const void*)fwd_megakernel, hipFuncAttributeMaxDynamicSharedMemorySize, LDS_BYTES);
        hipOccupancyMaxActiveBlocksPerMultiprocessor(&per_cu, (const void*)fwd_megakernel, NTHREADS, LDS_BYTES);
        if (per_cu < 1) { fprintf(stderr, "kernel_launch: occupancy query says %d blocks per CU\n", per_cu); per_cu = 1; }
        if (per_cu > 1) per_cu = 1;
        grid_blocks = cus * per_cu;
    }
    if (grid_blocks < 0) return;
    if (hipMemsetAsync((char*)d_ws + WS_BAR, 0, BAR_ZERO_BYTES, stream) != hipSuccess) { fprintf(stderr, "kernel_launch: memset of barrier words failed\n"); return; }
    Params p{};
    for (int i = 0; i < 21; ++i) p.in[i] = (const float*)d_in[i];
    p.out = (float*)d_out; p.ws = (unsigned char*)d_ws;
    void* args[] = {&p};
    hipError_t e = hipLaunchCooperativeKernel((const void*)fwd_megakernel, dim3(grid_blocks), dim3(NTHREADS), args, LDS_BYTES, stream);
    if (e != hipSuccess) fprintf(stderr, "cooperative launch failed: %s (grid %d)\n", hipGetErrorString(e), grid_blocks);
}
```
